# Optimizing an MI355X kernel written in HIP

```python
import jax, jax.numpy as jnp
from jax import lax
import numpy as np

D_MODEL = 4096
BATCH = 2
SEQ = 4096
DEPTH = 2

MEM_LEN = 256
N_MIXERS = 2
N_A_LAYERS = (DEPTH + 1) // 2
N_B_LAYERS = DEPTH // 2
X_HEADS = 4
X_WIDTH = D_MODEL // 4
X_HEAD_DIM = X_WIDTH // X_HEADS
MIX_WIDTH = D_MODEL - X_WIDTH
A_HEAD_DIM = 128
A_GROUPS = ((128, 1), (512, 4), (2048, 16))
A_HEADS = MIX_WIDTH // A_HEAD_DIM
A_HEADS_PER_GROUP = A_HEADS // len(A_GROUPS)
A_OUT_WIDTH = A_HEADS_PER_GROUP * A_HEAD_DIM
A_IN_COLS = 3 * MIX_WIDTH + X_WIDTH
BLOCK = 128
ROPE_THETA = 500000.0
ROT_DIM = A_HEAD_DIM // 4
R_HEAD_DIM = 64
R_HEADS = MIX_WIDTH // R_HEAD_DIM
D_DECAY = 128
D_AAA = 128
D_MV = 96
D_GATE = 480
B_SHIFT_COLS = 3 * MIX_WIDTH + D_DECAY + D_AAA + D_MV + D_GATE
B_IN_COLS = B_SHIFT_COLS + X_WIDTH
D_FF = 14336
CONV_WIDTH = 3
NORM_EPS = 1e-6
GN_EPS = 64e-5
L2_EPS = 1e-12
NEG_INF = -1e30

kernel_name = "hybrid_dilated_attn_rwkv7_convffn"


def _split(x, sizes):
    out, start = [], 0
    for s in sizes:
        out.append(x[..., start:start + s])
        start += s
    return out


def rmsnorm(x, g):
    xf = x.astype(jnp.float32)
    y = xf * lax.rsqrt(jnp.mean(xf * xf, axis=-1, keepdims=True) + NORM_EPS)
    return (y * g.astype(jnp.float32)).astype(x.dtype)


def partial_rope(x, positions):
    half = ROT_DIM // 2
    inv_freq = ROPE_THETA ** (-jnp.arange(half, dtype=jnp.float32) / half)
    ang = positions.astype(jnp.float32)[..., None] * inv_freq
    cos, sin = jnp.cos(ang)[:, :, None, :], jnp.sin(ang)[:, :, None, :]
    xr = x[..., :ROT_DIM].astype(jnp.float32)
    x1, x2 = xr[..., :half], xr[..., half:]
    rot = jnp.concatenate([x1 * cos - x2 * sin, x2 * cos + x1 * sin], axis=-1)
    return jnp.concatenate([rot.astype(x.dtype), x[..., ROT_DIM:]], axis=-1)


def dilated_window_attn(q, k, v, window, dilation):
    B, S, H, Dh = q.shape
    n_back = window // dilation
    assert n_back <= BLOCK
    span = dilation * BLOCK
    Sp = -(-S // span) * span
    L = Sp // dilation
    nb = L // BLOCK
    pad = ((0, 0), (0, Sp - S), (0, 0), (0, 0))

    def split(t):
        t = jnp.pad(t, pad).reshape(B, L, dilation, H, Dh).transpose(0, 2, 1, 3, 4)
        return t.reshape(B, dilation, nb, BLOCK, H, Dh)

    def with_prev(t):
        prev = jnp.pad(t, ((0, 0), (0, 0), (1, 0), (0, 0), (0, 0), (0, 0)))[:, :, :-1]
        return jnp.concatenate([prev, t], axis=3)

    qb = split(q)
    kb = with_prev(split(k))
    vb = with_prev(split(v))
    s = jnp.einsum('brnqhd,brnkhd->brnhqk', qb, kb,
                   preferred_element_type=jnp.float32) * (Dh ** -0.5)
    nidx = jnp.arange(nb)[:, None, None]
    qpos = nidx * BLOCK + jnp.arange(BLOCK)[None, :, None]
    kpos = nidx * BLOCK - BLOCK + jnp.arange(2 * BLOCK)[None, None, :]
    dist = qpos - kpos
    valid = (dist >= 0) & (dist <= n_back) & (kpos >= 0)
    s = jnp.where(valid[None, None, :, None, :, :], s, NEG_INF)
    m = jnp.max(s, axis=-1, keepdims=True)
    p = jnp.exp(s - m)
    l = jnp.sum(p, axis=-1, keepdims=True)
    o = jnp.einsum('brnhqk,brnkhd->brnqhd', p / l, vb.astype(jnp.float32))
    lse = (m + jnp.log(l))[..., 0]
    o = o.reshape(B, dilation, L, H, Dh).transpose(0, 2, 1, 3, 4).reshape(B, Sp, H, Dh)[:, :S]
    lse = lse.transpose(0, 1, 2, 4, 3).reshape(B, dilation, L, H).transpose(0, 2, 1, 3)
    lse = lse.reshape(B, Sp, H)[:, :S]
    return o, lse


def dilated_mixer(h, w_in, positions):
    B, S, _ = h.shape
    P = h @ w_in
    q, k, v, cq = _split(P, [MIX_WIDTH, MIX_WIDTH, MIX_WIDTH, X_WIDTH])
    qh = partial_rope(q.reshape(B, S, A_HEADS, A_HEAD_DIM), positions)
    kh = partial_rope(k.reshape(B, S, A_HEADS, A_HEAD_DIM), positions)
    vh = v.reshape(B, S, A_HEADS, A_HEAD_DIM)
    outs, lses = [], []
    for g, (window, dilation) in enumerate(A_GROUPS):
        sl = slice(g * A_HEADS_PER_GROUP, (g + 1) * A_HEADS_PER_GROUP)
        o, lse = dilated_window_attn(qh[:, :, sl], kh[:, :, sl], vh[:, :, sl], window, dilation)
        outs.append(o)
        lses.append(lse)
    wts = jax.nn.softmax(jnp.stack(lses, axis=0), axis=0)
    mix = jnp.sum(wts[..., None] * jnp.stack(outs, axis=0), axis=0)
    return mix.reshape(B, S, A_OUT_WIDTH).astype(h.dtype), cq, v


def wkv7_scan(r, w, k, v, a, b):
    B, S, H, N = r.shape

    def step(state, inp):
        r_t, w_t, k_t, v_t, a_t, b_t = inp
        sa = jnp.einsum('bhij,bhj->bhi', state, a_t)
        state = (state * w_t[:, :, None, :] + sa[..., None] * b_t[:, :, None, :]
                 + v_t[..., None] * k_t[:, :, None, :])
        return state, jnp.einsum('bhij,bhj->bhi', state, r_t)

    xs = tuple(t.transpose(1, 0, 2, 3) for t in (r, w, k, v, a, b))
    state0 = jnp.zeros((B, H, N, N), jnp.float32)
    _, ys = lax.scan(step, state0, xs)
    return ys.transpose(1, 0, 2, 3)


def rwkv7_mixer(h, v_first, w_in, shift_mu, w0, w_up, a0, a_up, v0, v_up, g_up,
                k_k, k_a, r_k, ln_g, ln_b):
    B, S, _ = h.shape
    f32 = jnp.float32
    P = h @ w_in
    Ps, cq = P[..., :B_SHIFT_COLS], P[..., B_SHIFT_COLS:]
    prev = jnp.pad(Ps, ((0, 0), (1, 0), (0, 0)))[:, :-1]
    Ps = Ps + (prev - Ps) * shift_mu
    r, k, v, wd, ad, vd, gd = _split(Ps, [MIX_WIDTH, MIX_WIDTH, MIX_WIDTH,
                                          D_DECAY, D_AAA, D_MV, D_GATE])
    w = -jax.nn.softplus(-(w0 + jnp.tanh(wd) @ w_up).astype(f32)) - 0.5
    decay = jnp.exp(-jnp.exp(w))
    a = jax.nn.sigmoid((a0 + ad @ a_up).astype(f32))
    v = v.astype(f32)
    v = v + (v_first.astype(f32) - v) * jax.nn.sigmoid((v0 + vd @ v_up).astype(f32))
    g = (jax.nn.sigmoid(gd) @ g_up).astype(f32)
    k = k.astype(f32)
    hs = lambda t: t.reshape(B, S, R_HEADS, R_HEAD_DIM)
    kk = hs(k * k_k.astype(f32))
    kk = kk / jnp.maximum(jnp.linalg.norm(kk, axis=-1, keepdims=True), L2_EPS)
    k = k * (1.0 + (a - 1.0) * k_a.astype(f32))
    rh, kh, vh, ah = hs(r.astype(f32)), hs(k), hs(v), hs(a)
    y = wkv7_scan(rh, hs(decay), kh, vh, -kk, kk * ah)
    mu = jnp.mean(y, axis=-1, keepdims=True)
    var = jnp.mean(jnp.square(y - mu), axis=-1, keepdims=True)
    y = ((y - mu) * lax.rsqrt(var + GN_EPS) * ln_g.astype(f32).reshape(R_HEADS, R_HEAD_DIM)
         + ln_b.astype(f32).reshape(R_HEADS, R_HEAD_DIM))
    y = y + jnp.sum(rh * kh * r_k.astype(f32), axis=-1, keepdims=True) * vh
    return (y.reshape(B, S, MIX_WIDTH) * g).astype(h.dtype), cq


def memory_cross_attn(cq, mem_k, mem_v):
    B, S, _ = cq.shape
    q = cq.reshape(B, S, X_HEADS, X_HEAD_DIM)
    s = jnp.einsum('bshd,bmhd->bhsm', q, mem_k,
                   preferred_element_type=jnp.float32) * (X_HEAD_DIM ** -0.5)
    p = jax.nn.softmax(s, axis=-1)
    o = jnp.einsum('bhsm,bmhd->bshd', p, mem_v.astype(jnp.float32))
    return o.reshape(B, S, X_WIDTH).astype(cq.dtype)


def conv_ffn(h, w_up, conv_w, conv_b, w_down):
    S = h.shape[1]
    gate, up = _split(h @ w_up, [D_FF, D_FF])
    gp = jnp.pad(gate, ((0, 0), (CONV_WIDTH - 1, 0), (0, 0)))
    gate = conv_b + sum(conv_w[j] * gp[:, j:j + S] for j in range(CONV_WIDTH))
    return (jax.nn.silu(gate) * up) @ w_down


def setup_inputs(seed: int = 0) -> dict:
    key = jax.random.key(seed)
    ks = jax.random.split(key, 32)
    f32 = jnp.float32
    nrm = lambda i, shape, scale: jax.random.normal(ks[i], shape, f32) * scale
    gain = lambda i, shape: 1.0 + nrm(i, shape, 0.02)
    NA, NB = N_A_LAYERS, N_B_LAYERS
    offset = jax.random.randint(ks[2], (BATCH, 1), 0, 4096, dtype=jnp.int32)
    positions = offset + jnp.arange(SEQ, dtype=jnp.int32)[None, :]
    return {
        "x": nrm(0, (BATCH, SEQ, D_MODEL), 1.0),
        "mem": nrm(1, (BATCH, MEM_LEN, D_MODEL), 1.0),
        "positions": positions,
        "mem_norm_g": gain(3, (D_MODEL,)),
        "mem_w_kv": nrm(4, (D_MODEL, 2 * X_WIDTH), D_MODEL ** -0.5),
        "a_norm_g": gain(5, (NA, D_MODEL)),
        "a_w_in": nrm(6, (NA, D_MODEL, A_IN_COLS), D_MODEL ** -0.5),
        "a_w_out": nrm(7, (NA, A_OUT_WIDTH + X_WIDTH, D_MODEL), (A_OUT_WIDTH + X_WIDTH) ** -0.5),
        "b_norm_g": gain(8, (NB, D_MODEL)),
        "b_w_in": nrm(9, (NB, D_MODEL, B_IN_COLS), D_MODEL ** -0.5),
        "b_shift_mu": jax.random.uniform(ks[10], (NB, B_SHIFT_COLS), f32),
        "b_w0": jax.random.uniform(ks[11], (NB, MIX_WIDTH), f32, minval=-6.0, maxval=-1.0),
        "b_w_up": nrm(12, (NB, D_DECAY, MIX_WIDTH), 0.5 * D_DECAY ** -0.5),
        "b_a0": nrm(13, (NB, MIX_WIDTH), 0.1),
        "b_a_up": nrm(14, (NB, D_AAA, MIX_WIDTH), D_AAA ** -0.5),
        "b_v0": nrm(15, (NB, MIX_WIDTH), 0.1),
        "b_v_up": nrm(16, (NB, D_MV, MIX_WIDTH), D_MV ** -0.5),
        "b_g_up": nrm(17, (NB, D_GATE, MIX_WIDTH), D_GATE ** -0.5),
        "b_k_k": 0.85 + nrm(18, (NB, MIX_WIDTH), 0.05),
        "b_k_a": 1.0 + nrm(19, (NB, MIX_WIDTH), 0.05),
        "b_r_k": nrm(20, (NB, R_HEADS, R_HEAD_DIM), 0.1),
        "b_ln_g": gain(21, (NB, MIX_WIDTH)),
        "b_ln_b": nrm(22, (NB, MIX_WIDTH), 0.02),
        "b_w_out": nrm(23, (NB, MIX_WIDTH + X_WIDTH, D_MODEL), (MIX_WIDTH + X_WIDTH) ** -0.5),
        "ffn_norm_g": gain(24, (DEPTH, D_MODEL)),
        "ffn_w_up": nrm(25, (DEPTH, D_MODEL, 2 * D_FF), D_MODEL ** -0.5),
        "ffn_conv_w": nrm(26, (DEPTH, CONV_WIDTH, D_FF), CONV_WIDTH ** -0.5),
        "ffn_conv_b": nrm(27, (DEPTH, D_FF), 0.02),
        "ffn_w_down": nrm(28, (DEPTH, D_FF, D_MODEL), D_FF ** -0.5),
        "final_norm_g": gain(29, (D_MODEL,)),
    }


def reference(x, mem, positions, mem_norm_g, mem_w_kv, a_norm_g, a_w_in, a_w_out,
              b_norm_g, b_w_in, b_shift_mu, b_w0, b_w_up, b_a0, b_a_up, b_v0, b_v_up,
              b_g_up, b_k_k, b_k_a, b_r_k, b_ln_g, b_ln_b, b_w_out,
              ffn_norm_g, ffn_w_up, ffn_conv_w, ffn_conv_b, ffn_w_down, final_norm_g):
    B, M, _ = mem.shape
    mem_k, mem_v = _split(rmsnorm(mem, mem_norm_g) @ mem_w_kv, [X_WIDTH, X_WIDTH])
    mem_k = mem_k.reshape(B, M, X_HEADS, X_HEAD_DIM)
    mem_v = mem_v.reshape(B, M, X_HEADS, X_HEAD_DIM)
    v_first = None
    for i in range(DEPTH):
        j = i // N_MIXERS
        if i % N_MIXERS == 0:
            h = rmsnorm(x, a_norm_g[j])
            mix, cq, v_attn = dilated_mixer(h, a_w_in[j], positions)
            if v_first is None:
                v_first = v_attn
            w_out = a_w_out[j]
        else:
            h = rmsnorm(x, b_norm_g[j])
            mix, cq = rwkv7_mixer(h, v_first, b_w_in[j], b_shift_mu[j], b_w0[j], b_w_up[j],
                                  b_a0[j], b_a_up[j], b_v0[j], b_v_up[j], b_g_up[j],
                                  b_k_k[j], b_k_a[j], b_r_k[j], b_ln_g[j], b_ln_b[j])
            w_out = b_w_out[j]
        xo = memory_cross_attn(cq, mem_k, mem_v)
        x = x + jnp.concatenate([mix, xo], axis=-1) @ w_out
        x = x + conv_ffn(rmsnorm(x, ffn_norm_g[i]), ffn_w_up[i], ffn_conv_w[i],
                         ffn_conv_b[i], ffn_w_down[i])
    return rmsnorm(x, final_norm_g)
```

```cpp
#include <hip/hip_runtime.h>
#include <cstdio>
#include <cstdint>
#define MK_ONE_LAUNCH 1
namespace pg8 {
#define PG8_LAS __attribute__((address_space(3)))
typedef unsigned short bf16_t;
typedef short bf16x8 __attribute__((ext_vector_type(8)));
typedef float f32x4 __attribute__((ext_vector_type(4)));
typedef unsigned u32x4 __attribute__((ext_vector_type(4)));
constexpr int BM = 256, BK = 64, HALF = 128, HTB = HALF * BK * 2  , STAGE_BYTES = 8 * HTB, NXCD = 8, WGM = 8;

__host__ __device__ __forceinline__ int lds_byte(int r, int c) { const int st = (r >> 4) * 2 + (c >> 5), rr = r & 15, cc = c & 31, ob = rr * 64 + cc * 2; return st * 1024 + (ob ^ (((ob >> 9) & 1) << 5)); }
__host__ __device__ __forceinline__ void stage_rc(int b, int& R, int& C) { const int st = b / 1024, sb = b % 1024, swz = sb ^ (((sb >> 9) & 1) << 5); R = (st >> 1) * 16 + swz / 64; C = (st & 1) * 32 + (swz % 64) / 2; }
__host__ __device__ __forceinline__ int perm32(int rho) { const int n = rho >> 4, i = rho & 15; return 8 * (i >> 2) + 4 * n + (i & 3); }

struct Unit { int pm, pn; };
struct Gemm { const bf16_t* A; const bf16_t* Bt; int M, N, K, lda, ldb; };

struct StaticOrder {
    int nM, nN, nwg, G, c;
    __host__ __device__ void init(int M, int N, int G_, int c_) { nM = M / BM; nN = N / BM; nwg = nM * nN; G = G_; c = c_; }
    __host__ __device__ bool next(int i, Unit& u) const {
        const long L = (long)i * G + c; if (L >= nwg) return false;
        int wgid = (int)L; { const int q = nwg / NXCD, r = nwg % NXCD, xcd = wgid % NXCD, off = wgid / NXCD; wgid = (xcd < r ? xcd * (q + 1) : r * (q + 1) + (xcd - r) * q) + off; }
        const int nig = WGM * nN, gid = wgid / nig, fm = gid * WGM, gsz = (nM - fm) < WGM ? (nM - fm) : WGM;
        u.pm = fm + ((wgid % nig) % gsz); u.pn = (wgid % nig) / gsz; return true;
    }
    __device__ __forceinline__ void a_ready(const Unit&) const {}
    __device__ __forceinline__ void done(const Unit&) const {}
};

__device__ __forceinline__ unsigned cvt_pk_bf16(float lo, float hi) { unsigned r; asm volatile("v_cvt_pk_bf16_f32 %0, %1, %2" : "=v"(r) : "v"(lo), "v"(hi)); return r; }

struct EpiBf16P {
    static constexpr bool PERM = true, AFTER_DRAIN = false;
    bf16_t* O; int ldc;
    __device__ __forceinline__ void operator()(const f32x4 (&acc)[2][2][4][2], const Unit& u, int, int, int, int) const {
        int t_ = threadIdx.x; asm volatile("" : "+v"(t_)); const int wid_ = __builtin_amdgcn_readfirstlane(t_ >> 6), wr = wid_ >> 2, wc = wid_ & 3, fr = t_ & 15, fq = (t_ >> 4) & 3;
        const int row0 = u.pm * BM + wr * 64 + fr; const int col0 = u.pn * BM + wc * 32 + 8 * fq;
#pragma unroll
        for (int ai = 0; ai < 2; ++ai)
#pragma unroll
            for (int m = 0; m < 4; ++m) { bf16_t* rowp = O + (size_t)(row0 + ai * HALF + m * 16) * ldc + col0;
#pragma unroll
                for (int bj = 0; bj < 2; ++bj) { const f32x4 v0 = acc[ai][bj][m][0], v1 = acc[ai][bj][m][1];
                    u32x4 w; w.x = cvt_pk_bf16(v0[0], v0[1]); w.y = cvt_pk_bf16(v0[2], v0[3]); w.z = cvt_pk_bf16(v1[0], v1[1]); w.w = cvt_pk_bf16(v1[2], v1[3]);
                    *(u32x4*)(rowp + bj * HALF) = w; } }
    }
};
struct EpiF32 {
    static constexpr bool PERM = false, AFTER_DRAIN = false;
    float* O; const float* R; int ldc;
    __device__ __forceinline__ void operator()(const f32x4 (&acc)[2][2][4][2], const Unit& u, int, int, int, int) const {
        int t_ = threadIdx.x; asm volatile("" : "+v"(t_)); const int wid_ = __builtin_amdgcn_readfirstlane(t_ >> 6), wr = wid_ >> 2, wc = wid_ & 3, fr = t_ & 15, fq = (t_ >> 4) & 3;
        const int row0 = u.pm * BM + wr * 64 + fr; const int col0 = u.pn * BM + wc * 32 + 4 * fq;
#pragma unroll
        for (int ai = 0; ai < 2; ++ai)
#pragma unroll
            for (int m = 0; m < 4; ++m) { const size_t off = (size_t)(row0 + ai * HALF + m * 16) * ldc + col0;
#pragma unroll
                for (int bj = 0; bj < 2; ++bj)
#pragma unroll
                    for (int n = 0; n < 2; ++n) { f32x4 v = acc[ai][bj][m][n]; const size_t o = off + bj * HALF + n * 16;
                        if (R) v = v + *(const f32x4*)(R + o);
                        *(f32x4*)(O + o) = v; } }
    }
};

template <class Epi, class Sched, bool ALIGN_EPI = false>
__device__ __forceinline__ void gemm_phase(PG8_LAS unsigned char* lds, const Gemm g, const Sched& S, const Epi& E) {
    int tid_ = threadIdx.x; asm volatile("" : "+v"(tid_));
    const int tid = tid_, wid = __builtin_amdgcn_readfirstlane(tid >> 6), lane = tid & 63, wr = wid >> 2, wc = wid & 3, fr = lane & 15, fq = lane >> 4;
    const int K = g.K, nt = K / BK;
    unsigned voffA[2], voffB[2];
#pragma unroll
    for (int i = 0; i < 2; ++i) { int R, C; stage_rc(tid * 16 + i * 8192, R, C); const int Rb = Epi::PERM ? ((R & ~31) + perm32(R & 31)) : R;
        voffA[i] = (unsigned)(R * g.lda + C) * 2u; voffB[i] = (unsigned)(Rb * g.ldb + C) * 2u; }
    const size_t kstep = (size_t)(BK * 2);
    const size_t hstepA = (size_t)HALF * g.lda * 2, hstepB = (size_t)HALF * g.ldb * 2;
    const size_t tstepA = 2 * hstepA, tstepB = 2 * hstepB;
    const unsigned ldsw = (unsigned)wid * 1024u;
    const int aoff = lds_byte(wr * 64 + fr, fq * 8), boff = lds_byte(wc * 32 + fr, fq * 8);
#define PG8_SA(b, h) (((b) * 2 + (h)) * HTB)
#define PG8_SB(b, h) ((4 + (b) * 2 + (h)) * HTB)
#define PG8_STAGE(bufoff, gbase, voff) do { _Pragma("unroll") for (int _i = 0; _i < 2; ++_i) \
        __builtin_amdgcn_global_load_lds((const unsigned*)((const char*)(gbase) + (voff)[_i]), (PG8_LAS unsigned*)(lds + (bufoff) + ldsw + _i * 8192), 16, 0, 0); } while (0)
#define PG8_LDA(dst, b, h) do { _Pragma("unroll") for (int m = 0; m < 4; ++m) _Pragma("unroll") for (int k = 0; k < 2; ++k) dst[m][k] = *(const PG8_LAS bf16x8*)(lds + PG8_SA(b, h) + aoff + m * 2048 + k * 1024); } while (0)
#define PG8_LDB(dst, b, h) do { _Pragma("unroll") for (int n = 0; n < 2; ++n) _Pragma("unroll") for (int k = 0; k < 2; ++k) dst[n][k] = *(const PG8_LAS bf16x8*)(lds + PG8_SB(b, h) + boff + n * 2048 + k * 1024); } while (0)
#define PG8_MMA(ai, bj, At, Bt) do { __builtin_amdgcn_s_setprio(1); _Pragma("unroll") for (int m = 0; m < 4; ++m) _Pragma("unroll") for (int n = 0; n < 2; ++n) _Pragma("unroll") for (int k = 0; k < 2; ++k) \
        acc[ai][bj][m][n] = __builtin_amdgcn_mfma_f32_16x16x32_bf16(Bt[n][k], At[m][k], acc[ai][bj][m][n], 0, 0, 0); __builtin_amdgcn_s_setprio(0); } while (0)
#define PG8_WAIT_V(n) asm volatile("s_waitcnt vmcnt(" #n ")" ::: "memory")
#define PG8_WAIT_L(n) asm volatile("s_waitcnt lgkmcnt(" #n ")" ::: "memory")
#define PG8_BAR __builtin_amdgcn_s_barrier()
#define PG8_SCHED __builtin_amdgcn_sched_barrier(0)
    Unit cur, nxt; int ui = 0;
    if (!S.next(0, cur)) return;
    f32x4 acc[2][2][4][2];
#pragma unroll
    for (int a = 0; a < 2; ++a)
#pragma unroll
        for (int b = 0; b < 2; ++b)
#pragma unroll
            for (int m = 0; m < 4; ++m)
#pragma unroll
                for (int n = 0; n < 2; ++n) acc[a][b][m][n] = (f32x4){0.f, 0.f, 0.f, 0.f};
    bf16x8 At[4][2], B0[2][2], B1[2][2];
    const char* cA = (const char*)g.A + (size_t)cur.pm * tstepA; const char* cB = (const char*)g.Bt + (size_t)cur.pn * tstepB;
    S.a_ready(cur);
    PG8_STAGE(PG8_SB(0, 0), cB, voffB); PG8_STAGE(PG8_SB(0, 1), cB + hstepB, voffB); PG8_STAGE(PG8_SA(0, 0), cA, voffA); PG8_STAGE(PG8_SA(0, 1), cA + hstepA, voffA);
    if (wr == 1) PG8_BAR;
    PG8_WAIT_V(2); PG8_BAR;
    PG8_STAGE(PG8_SB(1, 0), cB + kstep, voffB); PG8_STAGE(PG8_SA(1, 0), cA + kstep, voffA); PG8_STAGE(PG8_SB(1, 1), cB + hstepB + kstep, voffB);
    PG8_WAIT_V(6); PG8_BAR;
    for (;;) {
        const bool has_next = S.next(ui + 1, nxt);
        const char* nA = has_next ? (const char*)g.A + (size_t)nxt.pm * tstepA : cA; const char* nB = has_next ? (const char*)g.Bt + (size_t)nxt.pn * tstepB : cB;
        for (int t = 0; t < nt; t += 2) {
            const bool last = (t == nt - 2);
            const char* a1 = cA + (size_t)(t + 1) * kstep;
            const char* a2 = last ? nA : cA + (size_t)(t + 2) * kstep; const char* b2 = last ? nB : cB + (size_t)(t + 2) * kstep;
            const char* a3 = a2 + kstep; const char* b3 = b2 + kstep;
            if (last && has_next) S.a_ready(nxt);
            PG8_LDB(B0, 0, 0); PG8_LDB(B1, 0, 1); PG8_SCHED; PG8_LDA(At, 0, 0); PG8_STAGE(PG8_SA(1, 1), a1 + hstepA, voffA);
            PG8_WAIT_V(8); PG8_WAIT_L(0); PG8_BAR; PG8_MMA(0, 0, At, B0); PG8_MMA(0, 1, At, B1); PG8_BAR; PG8_SCHED;
            PG8_LDA(At, 0, 1); PG8_STAGE(PG8_SB(0, 0), b2, voffB); PG8_STAGE(PG8_SB(0, 1), b2 + hstepB, voffB); PG8_STAGE(PG8_SA(0, 0), a2, voffA);
            PG8_WAIT_V(8); PG8_WAIT_L(0); PG8_BAR; PG8_MMA(1, 0, At, B0); PG8_MMA(1, 1, At, B1); PG8_BAR; PG8_SCHED;
            PG8_LDB(B0, 1, 0); PG8_LDB(B1, 1, 1); PG8_SCHED; PG8_LDA(At, 1, 0); PG8_STAGE(PG8_SA(0, 1), a2 + hstepA, voffA);
            PG8_WAIT_V(8); PG8_WAIT_L(0); PG8_BAR; PG8_MMA(0, 0, At, B0); PG8_MMA(0, 1, At, B1); PG8_BAR; PG8_SCHED;
            PG8_LDA(At, 1, 1); PG8_STAGE(PG8_SB(1, 0), b3, voffB); PG8_STAGE(PG8_SB(1, 1), b3 + hstepB, voffB); PG8_STAGE(PG8_SA(1, 0), a3, voffA);
            PG8_WAIT_V(8); PG8_WAIT_L(0); PG8_BAR; PG8_MMA(1, 0, At, B0); PG8_MMA(1, 1, At, B1); PG8_BAR; PG8_SCHED;
        }
        if constexpr (ALIGN_EPI) { if (wr == 0) PG8_BAR; }
        E(acc, cur, wr, wc, fr, fq); S.done(cur);
        if (!has_next) break;
#pragma unroll
        for (int a = 0; a < 2; ++a)
#pragma unroll
            for (int b = 0; b < 2; ++b)
#pragma unroll
                for (int m = 0; m < 4; ++m)
#pragma unroll
                    for (int n = 0; n < 2; ++n) acc[a][b][m][n] = (f32x4){0.f, 0.f, 0.f, 0.f};
        cur = nxt; cA = nA; cB = nB; ++ui;
        if constexpr (ALIGN_EPI) { if (wr == 1) PG8_BAR; }
    }
    PG8_WAIT_V(0);
    if constexpr (!ALIGN_EPI) { if (wr == 0) PG8_BAR; }
    PG8_BAR;
#undef PG8_SA
#undef PG8_SB
#undef PG8_STAGE
#undef PG8_LDA
#undef PG8_LDB
#undef PG8_MMA
#undef PG8_WAIT_V
#undef PG8_WAIT_L
#undef PG8_BAR
#undef PG8_SCHED
}
}
constexpr int NWAVES = 8, NTHREADS = 512;
constexpr int BATCH = 2, SEQ = 4096, DM = 4096, NTOK = BATCH * SEQ;
constexpr int MEM_LEN = 256, NMEM = BATCH * MEM_LEN;
constexpr int XW = 1024, XH = 4, XHD = 256, MIXW = 3072;
constexpr int A_IN = 10240, A_OUTW = 1024, A_CAT = 2048;
constexpr int B_SHIFT = 10048, B_IN = 11072, B_IN_PAD = 11264;
constexpr int LDP = 11264;
constexpr int DFF = 14336, DFF2 = 28672;
constexpr int RH = 48, RHD = 64;
constexpr float NORM_EPS = 1e-6f, GN_EPS = 64e-5f;
constexpr int PB_R = 0, PB_K = 3072, PB_V = 6144, PB_WD = 9216, PB_AD = 9344, PB_VD = 9472, PB_GD = 9568, PB_CQ = 10048;
constexpr int PA_Q = 0, PA_K = 3072, PA_V = 6144, PA_CQ = 9216;

constexpr size_t MiB = 1u << 20;
constexpr size_t WS_CTL = 0, CTL_ZERO_BYTES = 65536;
constexpr size_t WS_ROPE = 1 * MiB;
constexpr size_t WS_WKV = 2 * MiB;
constexpr size_t WS_WAIN = 18 * MiB;
constexpr size_t WS_WAOUT = 98 * MiB;
constexpr size_t WS_WBIN = 114 * MiB;
constexpr size_t WS_WLW = 202 * MiB;
constexpr size_t WS_WLA = WS_WLW + 3 * MiB / 2;
constexpr size_t WS_WLV = WS_WLA + 3 * MiB / 2;
constexpr size_t WS_WLG = WS_WLV + 3 * MiB / 2;
constexpr size_t WS_WBOUT = 210 * MiB;
constexpr size_t WS_WUP = 242 * MiB;
constexpr size_t WS_WDOWN = 690 * MiB;
constexpr size_t WS_X = 914 * MiB;
constexpr size_t WS_H = 1042 * MiB;
constexpr size_t WS_MEMN = 1106 * MiB;
constexpr size_t WS_MEMKV = 1110 * MiB;
constexpr size_t WS_P = 1112 * MiB;
constexpr size_t WS_VFIRST = 1288 * MiB;
constexpr size_t WS_CAT = 1336 * MiB;
constexpr size_t WS_ACT = 1400 * MiB;
constexpr size_t WS_GU = 1624 * MiB;
constexpr size_t WS_HALO = 1624 * MiB, WS_RAWG = 1640 * MiB, WS_RAWU = 1656 * MiB;
constexpr size_t WS_CH = 1680 * MiB;
constexpr size_t WS_SR = 2072 * MiB;
constexpr size_t WS_SW = WS_SR + 96 * MiB, WS_SK = WS_SR + 192 * MiB, WS_SV = WS_SR + 288 * MiB, WS_SA = WS_SR + 384 * MiB, WS_SB = WS_SR + 480 * MiB;
constexpr size_t WS_G = 2648 * MiB;
constexpr size_t WS_Y = 2744 * MiB;
constexpr size_t WS_VT = 2840 * MiB;
constexpr size_t WS_OG = 2840 * MiB;
constexpr size_t WS_LSE = 2936 * MiB;
constexpr size_t WS_LA = 2937 * MiB;
constexpr size_t WS_MEMVT = 2953 * MiB;
constexpr size_t WS_END = 2954 * MiB;
constexpr int CW_TMO = 0, CW_CODE = 1, CW_BAR = 4096;

constexpr int RING_OFF = 0, RING_BYTES = 131072;
constexpr int LDSCTL_OFF = RING_BYTES, MISC_OFF = LDSCTL_OFF + 320;
constexpr int LDS_BYTES = 147456;

#define GAS __attribute__((address_space(1)))
#define LAS __attribute__((address_space(3)))
typedef unsigned short bf16;
typedef unsigned v4u __attribute__((ext_vector_type(4)));
typedef unsigned v2u __attribute__((ext_vector_type(2)));
typedef float f32x4 __attribute__((ext_vector_type(4)));
typedef float f32x2 __attribute__((ext_vector_type(2)));
typedef GAS unsigned gu32;
#define RLX_AGENT __ATOMIC_RELAXED, __HIP_MEMORY_SCOPE_AGENT
#define LDS_WAIT() asm volatile("s_waitcnt lgkmcnt(0)" ::: "memory")
#define VM_WAIT() asm volatile("s_waitcnt vmcnt(0)" ::: "memory")
__device__ __forceinline__ unsigned f2bf(float f) { unsigned u = __builtin_bit_cast(unsigned, f); return (u + 0x7fffu + ((u >> 16) & 1u)) >> 16; }
__device__ __forceinline__ unsigned pk2(float lo, float hi) { return f2bf(lo) | (f2bf(hi) << 16); }
__device__ __forceinline__ float bf2f(unsigned short h) { return __builtin_bit_cast(float, (unsigned)h << 16); }
__device__ __forceinline__ float bflo(unsigned w) { return __builtin_bit_cast(float, w << 16); }
__device__ __forceinline__ float bfhi(unsigned w) { return __builtin_bit_cast(float, w & 0xffff0000u); }
__device__ __forceinline__ float sigmoidf_(float x) { return 1.f / (1.f + __expf(-x)); }

#define XB_TMO      128
#define XB_XCNT(j)  (256  + 64 * (j))
#define XB_XSUB(j)  (1280 + 64 * (j))
#define XB_XGEN(j)  (2304 + 64 * (j))
#define XB_TOP      3328
#define XB_TOPGEN   3392
#define XCD_BAR_WORDS 3456
#define XB_SPIN_CAP (1u << 22)

__device__ __forceinline__ unsigned xb_ld(unsigned* p)              { return __hip_atomic_load(p, __ATOMIC_RELAXED, __HIP_MEMORY_SCOPE_AGENT); }
__device__ __forceinline__ unsigned xb_add(unsigned* p, unsigned v) { return __hip_atomic_fetch_add(p, v, __ATOMIC_RELAXED, __HIP_MEMORY_SCOPE_AGENT); }
__device__ __forceinline__ unsigned xb_xcc_id() { return (unsigned)__builtin_amdgcn_s_getreg((3 << 11) | 20) & 0xFu; }
#define XB_SPIN(cond, bar) do { unsigned _sp = 0; while (cond) { __builtin_amdgcn_s_sleep(1); \
    if ((++_sp & 255u) == 0u) { if (xb_ld(&(bar)[XB_TMO])) break; if (_sp > XB_SPIN_CAP) { atomicAdd(&(bar)[XB_TMO], 1u); break; } } } } while (0)

struct XcdBarrier {
    unsigned* bar; unsigned x;
    volatile LAS unsigned* st;
};
__device__ __forceinline__ XcdBarrier xcd_barrier_post(unsigned* bar, volatile LAS unsigned* st) {
    XcdBarrier b; b.bar = bar; b.x = xb_xcc_id(); b.st = st;
    if (threadIdx.x == 0) (void)xb_add(&bar[XB_XCNT(b.x)], 1u);
    return b;
}
__device__ __forceinline__ void xcd_barrier_complete(unsigned* bar, unsigned x, unsigned& nloc, unsigned& nx) {
    const unsigned G = gridDim.x * gridDim.y * gridDim.z;
    unsigned sum, cnt, mine, sp = 0u;
    for (;;) {
        sum = 0u; cnt = 0u; mine = 0u;
#pragma unroll
        for (unsigned j = 0; j < 16; ++j) { const unsigned c = xb_ld(&bar[XB_XCNT(j)]); sum += c; cnt += (c > 0u) ? 1u : 0u; mine = (j == x) ? c : mine; }
        if (sum == G) break;
        __builtin_amdgcn_s_sleep(1);
        if ((++sp & 255u) == 0u) { if (xb_ld(&bar[XB_TMO])) break; if (sp > XB_SPIN_CAP) { atomicAdd(&bar[XB_TMO], 1u); break; } }
    }
    nloc = mine > 0u ? mine : 1u; nx = cnt > 0u ? cnt : 1u;
}
__device__ __forceinline__ void xcd_barrier(const XcdBarrier& b) {
    asm volatile("s_waitcnt vmcnt(0)" ::: "memory");
    __syncthreads();
    if (threadIdx.x == 0) {
        unsigned* bar = b.bar;
        __builtin_amdgcn_s_waitcnt(0);
        unsigned nloc = b.st[0], nx = b.st[1];
        if (nloc == 0u) { xcd_barrier_complete(bar, b.x, nloc, nx); b.st[0] = nloc; b.st[1] = nx; }
        const unsigned old = xb_add(&bar[XB_XSUB(b.x)], 1u);
        const unsigned gen = old / nloc;
        if (old + 1u == (gen + 1u) * nloc) {
            __builtin_amdgcn_fence(__ATOMIC_RELEASE, "agent");
            asm volatile("s_waitcnt vmcnt(0)" ::: "memory");
            const unsigned og = xb_add(&bar[XB_TOP], 1u);
            const unsigned tg = og / nx;
            if (og + 1u == (tg + 1u) * nx) xb_add(&bar[XB_TOPGEN], 1u);
            else XB_SPIN(xb_ld(&bar[XB_TOPGEN]) == tg, bar);
            __builtin_amdgcn_fence(__ATOMIC_ACQUIRE, "agent");
            xb_add(&bar[XB_XGEN(b.x)], 1u);
            asm volatile("s_waitcnt vmcnt(0)" ::: "memory");
        } else {
            XB_SPIN(xb_ld(&bar[XB_XGEN(b.x)]) == gen, bar);
            __builtin_amdgcn_fence(__ATOMIC_ACQUIRE, "agent");
            asm volatile("s_waitcnt vmcnt(0)" ::: "memory");
        }
    }
    __syncthreads();
}

template <int CTRL> __device__ __forceinline__ float dppf(float x) { return __builtin_bit_cast(float, __builtin_amdgcn_update_dpp(0, __builtin_bit_cast(int, x), CTRL, 0xf, 0xf, true)); }
__device__ __forceinline__ float row16_sum(float x) { x += dppf<0xB1>(x); x += dppf<0x4E>(x); x += dppf<0x141>(x); x += dppf<0x140>(x); return x; }

__device__ __forceinline__ float wave_sum_dpp(float x) {
    x = row16_sum(x);
    x += __builtin_bit_cast(float, __builtin_amdgcn_update_dpp(0, __builtin_bit_cast(int, x), 0x142, 0xa, 0xf, false));
    x += __builtin_bit_cast(float, __builtin_amdgcn_update_dpp(0, __builtin_bit_cast(int, x), 0x143, 0xc, 0xf, false));
    return __builtin_bit_cast(float, __builtin_amdgcn_readlane(__builtin_bit_cast(int, x), 63));
}
__device__ __forceinline__ float wave_sum(float v) { return wave_sum_dpp(v); }
struct Ctx { int tid, lane, wave, gw, NGW, gtid, GT; LAS unsigned char* lds; };

__device__ __forceinline__ void convert_job(const Ctx& C, const float* W, int K, int N, bf16* WT, int ldk, int koff, int Kpad, int mode) {
    LAS float* scr = (LAS float*)(C.lds + RING_OFF + C.wave * 16384);
    const int nblk = N / 32, nitems = (Kpad / 64) * nblk, lane = C.lane;
    for (int item = C.gw; item < nitems; item += C.NGW) {
        const int kb = item / nblk, nb = item % nblk, k0 = 64 * kb, n0 = 32 * nb;
#pragma unroll 8
        for (int i = 0; i < 32; ++i) { const int kk = 2 * i + (lane >> 5); const int ks = k0 + kk - koff;
            float v = 0.f; if (ks >= 0 && ks < K) v = W[(size_t)ks * N + n0 + (lane & 31)];
            scr[kk * 33 + (lane & 31)] = v; }
        LDS_WAIT(); asm volatile("" ::: "memory");
        const int c = lane & 7;
        int d0 = n0;
        if (mode == 1) { d0 = (n0 < DFF) ? (256 * (n0 / 128) + (n0 % 128)) : (256 * ((n0 - DFF) / 128) + 128 + ((n0 - DFF) % 128)); }
#pragma unroll
        for (int j = 0; j < 4; ++j) { const int n = (lane >> 3) + 8 * j; const LAS float* s = scr + (8 * c) * 33 + n;
            v4u o; o.x = pk2(s[0 * 33], s[1 * 33]); o.y = pk2(s[2 * 33], s[3 * 33]); o.z = pk2(s[4 * 33], s[5 * 33]); o.w = pk2(s[6 * 33], s[7 * 33]);
            *(v4u*)(WT + (size_t)(d0 + n) * ldk + k0 + 8 * c) = o; }
        LDS_WAIT(); asm volatile("" ::: "memory");
    }
}

template <bool OUT_F32>
__device__ __forceinline__ void rmsnorm_rows_b(const Ctx& C, const bf16* X, const float* g, void* out, int nrows) {
    for (int row = C.gw; row < nrows; row += C.NGW) {
        const v4u* xr = (const v4u*)(X + (size_t)row * DM) + C.lane;
        float v[8][8]; float s = 0.f;
#pragma unroll
        for (int j = 0; j < 8; ++j) { const v4u w = xr[64 * j];
#pragma unroll
            for (int e = 0; e < 4; ++e) { v[j][2 * e] = bflo(w[e]); v[j][2 * e + 1] = bfhi(w[e]); s += v[j][2 * e] * v[j][2 * e] + v[j][2 * e + 1] * v[j][2 * e + 1]; } }
        const float rstd = 1.f / sqrtf(wave_sum(s) * (1.f / DM) + NORM_EPS);
#pragma unroll
        for (int j = 0; j < 8; ++j) { const int c0 = 8 * (C.lane + 64 * j); const f32x4 g0 = *(const f32x4*)(g + c0), g1 = *(const f32x4*)(g + c0 + 4);
            float y[8];
#pragma unroll
            for (int e = 0; e < 4; ++e) { y[e] = v[j][e] * rstd * g0[e]; y[4 + e] = v[j][4 + e] * rstd * g1[e]; }
            if (OUT_F32) { float* op = (float*)out + (size_t)row * DM + c0; *(f32x4*)op = (f32x4){y[0], y[1], y[2], y[3]}; *(f32x4*)(op + 4) = (f32x4){y[4], y[5], y[6], y[7]}; }
            else { v4u w; w.x = pk2(y[0], y[1]); w.y = pk2(y[2], y[3]); w.z = pk2(y[4], y[5]); w.w = pk2(y[6], y[7]); *(v4u*)((bf16*)out + (size_t)row * DM + c0) = w; } }
    }
}
template <bool OUT_F32>
__device__ __forceinline__ void rmsnorm_rows(const Ctx& C, const float* X, const float* g, void* out, int nrows) {
    for (int row = C.gw; row < nrows; row += C.NGW) {
        const f32x4* xr = (const f32x4*)(X + (size_t)row * DM) + C.lane;
        f32x4 v[16]; float s = 0.f;
#pragma unroll
        for (int j = 0; j < 16; ++j) { v[j] = xr[64 * j]; s += (v[j].x * v[j].x + v[j].y * v[j].y) + (v[j].z * v[j].z + v[j].w * v[j].w); }
        const float rstd = 1.f / sqrtf(wave_sum(s) * (1.f / DM) + NORM_EPS);
        const f32x4* gr = (const f32x4*)g + C.lane;
#pragma unroll
        for (int j = 0; j < 16; ++j) { const f32x4 gg = gr[64 * j]; const f32x4 y = v[j] * rstd * gg;
            if (OUT_F32) ((f32x4*)((float*)out + (size_t)row * DM) + C.lane)[64 * j] = y;
            else { v2u w; w.x = pk2(y.x, y.y); w.y = pk2(y.z, y.w); ((v2u*)((bf16*)out + (size_t)row * DM) + C.lane)[64 * j] = w; } }
    }
}

__device__ __forceinline__ void rope_table(const Ctx& C, const int* pos, float* T) {
    for (int idx = C.gtid; idx < NTOK * 16; idx += C.GT) { const int row = idx >> 4, i = idx & 15;
        const float inv = powf(500000.0f, -(float)i / 16.0f); const float ang = (float)pos[row] * inv;
        T[2 * idx] = cosf(ang); T[2 * idx + 1] = sinf(ang); }
}


__device__ __forceinline__ float shiftv(const bf16* P, int row, int t, int c, const float* mu) {
    const float cur = bf2f(P[(size_t)row * LDP + c]); const float prev = (t > 0) ? bf2f(P[(size_t)(row - 1) * LDP + c]) : 0.f;
    return cur + (prev - cur) * mu[c];
}
__device__ __forceinline__ void prep_b1(const Ctx& C, const bf16* P, const float* mu, bf16* LA) {
    for (int idx = C.gtid; idx < NTOK * 128; idx += C.GT) { const int row = idx >> 7, c = (idx & 127) * 8, t = row & (SEQ - 1);
        int src = -1, mode = 0;
        if (c < 128) { src = PB_WD + c; mode = 1; } else if (c < 256) { src = PB_AD + (c - 128); mode = 2; } else if (c < 352) { src = PB_VD + (c - 256); mode = 2; }
        else if (c >= 512 && c < 992) { src = PB_GD + (c - 512); mode = 3; }
        v4u o = (v4u){0u, 0u, 0u, 0u};
        if (src >= 0) { const v4u cw = *(const v4u*)(P + (size_t)row * LDP + src); v4u pw = (v4u){0u, 0u, 0u, 0u}; if (t > 0) pw = *(const v4u*)(P + (size_t)(row - 1) * LDP + src);
            const f32x4 m0 = *(const f32x4*)(mu + src), m1 = *(const f32x4*)(mu + src + 4);
            float r[8];
#pragma unroll
            for (int e = 0; e < 8; ++e) { const float cur = (e & 1) ? bfhi(cw[e >> 1]) : bflo(cw[e >> 1]), prv = (e & 1) ? bfhi(pw[e >> 1]) : bflo(pw[e >> 1]), mm = (e < 4) ? m0[e & 3] : m1[e & 3];
                const float x = cur + (prv - cur) * mm; r[e] = (mode == 1) ? tanhf(x) : ((mode == 3) ? sigmoidf_(x) : x); }
            o.x = pk2(r[0], r[1]); o.y = pk2(r[2], r[3]); o.z = pk2(r[4], r[5]); o.w = pk2(r[6], r[7]); }
        *(v4u*)(LA + (size_t)row * 1024 + c) = o; }
}

typedef short bf16x8v __attribute__((ext_vector_type(8)));
typedef short bf16x4v __attribute__((ext_vector_type(4)));


__device__ __forceinline__ float SFMA(float a, float b, float c) { float d; asm("v_fma_f32 %0, %1, %2, %3" : "=v"(d) : "v"(a), "v"(b), "v"(c)); return d; }
__device__ __forceinline__ float SMUL(float a, float b) { float d; asm("v_mul_f32 %0, %1, %2" : "=v"(d) : "v"(a), "v"(b)); return d; }
constexpr int SC_T = 32, SC_N = SC_T * 64, SC_BUF = 6 * SC_N;

namespace pg8 {
template <int MODE> struct EpiLora {
    static constexpr bool PERM = true, AFTER_DRAIN = false;
    bf16_t* O; const float* bias; const bf16_t* P; const float* mu; const bf16_t* VF; bf16_t* O2; const float* bias2;
    __device__ __forceinline__ void operator()(const f32x4 (&acc)[2][2][4][2], const Unit& u, int, int, int, int) const {
        int t_ = threadIdx.x; asm volatile("" : "+v"(t_)); const int wid_ = __builtin_amdgcn_readfirstlane(t_ >> 6), wr = wid_ >> 2, wc = wid_ & 3, fr = t_ & 15, fq = (t_ >> 4) & 3;
        if constexpr (MODE == 2) {
            const int row0 = u.pm * BM + wr * 64 + fr; const int colt = u.pn * BM + wc * 32 + 8 * fq;
#pragma unroll
            for (int bj = 0; bj < 2; ++bj) { const int c = colt + bj * HALF;
                const f32x4 b0 = *(const f32x4*)(bias + c), b1 = *(const f32x4*)(bias + c + 4), m0 = *(const f32x4*)(mu + PB_V + c), m1 = *(const f32x4*)(mu + PB_V + c + 4);
#pragma unroll
                for (int ai = 0; ai < 2; ++ai)
#pragma unroll
                    for (int m = 0; m < 4; ++m) { const int row = row0 + ai * HALF + m * 16; const int t = row & (SEQ - 1);
                        const u32x4 cw = *(const u32x4*)(P + (size_t)row * LDP + PB_V + c); u32x4 pw = (u32x4){0u, 0u, 0u, 0u}; if (t > 0) pw = *(const u32x4*)(P + (size_t)(row - 1) * LDP + PB_V + c);
                        const u32x4 fw = *(const u32x4*)(VF + (size_t)row * MIXW + c);
                        f32x4 v0 = acc[ai][bj][m][0], v1 = acc[ai][bj][m][1];
#pragma unroll
                        for (int e = 0; e < 4; ++e) {
                            { const unsigned cwe = cw[e >> 1], pwe = pw[e >> 1], fwe = fw[e >> 1]; const float cur = (e & 1) ? bfhi(cwe) : bflo(cwe), prv = (e & 1) ? bfhi(pwe) : bflo(pwe), vf = (e & 1) ? bfhi(fwe) : bflo(fwe);
                              const float gt = __builtin_amdgcn_rcpf(1.f + __expf(-(b0[e] + v0[e]))); const float vs = cur + (prv - cur) * m0[e]; v0[e] = vs + (vf - vs) * gt; }
                            { const unsigned cwe = cw[2 + (e >> 1)], pwe = pw[2 + (e >> 1)], fwe = fw[2 + (e >> 1)]; const float cur = (e & 1) ? bfhi(cwe) : bflo(cwe), prv = (e & 1) ? bfhi(pwe) : bflo(pwe), vf = (e & 1) ? bfhi(fwe) : bflo(fwe);
                              const float gt = __builtin_amdgcn_rcpf(1.f + __expf(-(b1[e] + v1[e]))); const float vs = cur + (prv - cur) * m1[e]; v1[e] = vs + (vf - vs) * gt; } }
                        u32x4 w_; w_.x = cvt_pk_bf16(v0[0], v0[1]); w_.y = cvt_pk_bf16(v0[2], v0[3]); w_.z = cvt_pk_bf16(v1[0], v1[1]); w_.w = cvt_pk_bf16(v1[2], v1[3]);
                        *(u32x4*)(O + (size_t)row * MIXW + c) = w_; }
                asm volatile("" ::: "memory"); }
        } else {
            const int row0 = u.pm * BM + wr * 64 + fr; const int colt = u.pn * BM + wc * 32 + 8 * fq;
            const bool isw = (MODE == 4) ? (u.pn < 12) : true;
            const float sc_ = (MODE == 0 || (MODE == 4 && isw)) ? -0.6065306597126334f : 1.f;
            const float* bp = (MODE == 4 && !isw) ? bias2 : bias; bf16_t* Op = (MODE == 4 && !isw) ? O2 : O;
#pragma unroll
            for (int bj = 0; bj < 2; ++bj) { const int c = ((MODE == 4 && !isw) ? colt - MIXW : colt) + bj * HALF;
                f32x4 b0 = (f32x4){0.f, 0.f, 0.f, 0.f}, b1 = b0;
                if (MODE != 3) { b0 = *(const f32x4*)(bp + c); b1 = *(const f32x4*)(bp + c + 4); }
#pragma unroll
                for (int ai = 0; ai < 2; ++ai)
#pragma unroll
                    for (int m = 0; m < 4; ++m) { const int row = row0 + ai * HALF + m * 16;
                        f32x4 v0 = acc[ai][bj][m][0], v1 = acc[ai][bj][m][1];
                        if (MODE != 3) {
#pragma unroll
                            for (int e = 0; e < 4; ++e) { v0[e] = sc_ * __builtin_amdgcn_rcpf(1.f + __expf(-(b0[e] + v0[e]))); v1[e] = sc_ * __builtin_amdgcn_rcpf(1.f + __expf(-(b1[e] + v1[e]))); } }
                        u32x4 w_; w_.x = cvt_pk_bf16(v0[0], v0[1]); w_.y = cvt_pk_bf16(v0[2], v0[3]); w_.z = cvt_pk_bf16(v1[0], v1[1]); w_.w = cvt_pk_bf16(v1[2], v1[3]);
                        *(u32x4*)(Op + (size_t)row * MIXW + c) = w_; }
                asm volatile("" ::: "memory"); }
        }
    }
};
template <bool R_F32> struct EpiResB {
    static constexpr bool PERM = true, AFTER_DRAIN = false;
    bf16_t* XO; const void* R;
    __device__ __forceinline__ void operator()(const f32x4 (&acc)[2][2][4][2], const Unit& u, int, int, int, int) const {
        int t_ = threadIdx.x; asm volatile("" : "+v"(t_)); const int wid_ = __builtin_amdgcn_readfirstlane(t_ >> 6), wr = wid_ >> 2, wc = wid_ & 3, fr = t_ & 15, fq = (t_ >> 4) & 3;
        const int row0 = u.pm * BM + wr * 64 + fr; const int col0 = u.pn * BM + wc * 32 + 8 * fq;
#pragma unroll
        for (int ai = 0; ai < 2; ++ai)
#pragma unroll
            for (int m = 0; m < 4; ++m) { const size_t off = (size_t)(row0 + ai * HALF + m * 16) * DM + col0;
#pragma unroll
                for (int bj = 0; bj < 2; ++bj) { f32x4 v0 = acc[ai][bj][m][0], v1 = acc[ai][bj][m][1];
                    if (R_F32) { const float* rp = (const float*)R + off + bj * HALF; v0 = v0 + *(const f32x4*)rp; v1 = v1 + *(const f32x4*)(rp + 4); }
                    else { const u32x4 rw = *(const u32x4*)((const bf16_t*)R + off + bj * HALF);
                        v0 = v0 + (f32x4){bflo(rw.x), bfhi(rw.x), bflo(rw.y), bfhi(rw.y)}; v1 = v1 + (f32x4){bflo(rw.z), bfhi(rw.z), bflo(rw.w), bfhi(rw.w)}; }
                    u32x4 w; w.x = cvt_pk_bf16(v0[0], v0[1]); w.y = cvt_pk_bf16(v0[2], v0[3]); w.z = cvt_pk_bf16(v1[0], v1[1]); w.w = cvt_pk_bf16(v1[2], v1[3]);
                    *(u32x4*)(XO + off + bj * HALF) = w; }
                if (m & 1) asm volatile("" ::: "memory"); }
    }
};
}

__device__ __forceinline__ void convert_fast(const Ctx& C, const float* W, int K, int N, bf16* WT, int ldk, int mode, int gw0 = -1, int ngw = 0) {
    if (gw0 < 0) { gw0 = C.gw; ngw = C.NGW; }
    constexpr int PITCH = 144;
    LAS unsigned char* T = C.lds + RING_OFF + C.wave * 16384;
    const int nblk = N / 64, nitems = (K / 64) * nblk, lane = C.lane, nq = lane & 15, kg = lane >> 4;
    for (int item = gw0; item < nitems; item += ngw) {
        const int kb = item / nblk, nb = item % nblk, k0 = 64 * kb, n0 = 64 * nb;
        f32x4 v[2][8];
#pragma unroll
        for (int h = 0; h < 2; ++h)
#pragma unroll
            for (int e = 0; e < 8; ++e) v[h][e] = *(const f32x4*)(W + (size_t)(k0 + 32 * h + 8 * kg + e) * N + n0 + 4 * nq);
#pragma unroll
        for (int h = 0; h < 2; ++h)
#pragma unroll
            for (int j = 0; j < 4; ++j) { v4u o; o.x = pk2(v[h][0][j], v[h][1][j]); o.y = pk2(v[h][2][j], v[h][3][j]); o.z = pk2(v[h][4][j], v[h][5][j]); o.w = pk2(v[h][6][j], v[h][7][j]);
                *(LAS v4u*)(T + (4 * nq + j) * PITCH + (32 * h + 8 * kg) * 2) = o; }
        LDS_WAIT(); asm volatile("" ::: "memory");
        int d0 = n0;
        if (mode == 1) { d0 = (n0 < DFF) ? (256 * (n0 / 128) + (n0 % 128)) : (256 * ((n0 - DFF) / 128) + 128 + ((n0 - DFF) % 128)); }
#pragma unroll
        for (int s = 0; s < 8; ++s) { const int n = 8 * s + (lane >> 3), kc = lane & 7;
            const v4u o = *(const LAS v4u*)(T + n * PITCH + kc * 16);
            *(v4u*)(WT + (size_t)(d0 + n) * ldk + k0 + 8 * kc) = o; }
        LDS_WAIT(); asm volatile("" ::: "memory");
    }
}

__device__ __forceinline__ void vt_build(const Ctx& C, const bf16* VF, bf16* VT, int gw0, int ngw) {
    constexpr int PITCH = 272;
    LAS unsigned char* T = C.lds + RING_OFF + C.wave * 16384;
    const int lane = C.lane;
    for (int item = gw0; item < BATCH * 24 * 128; item += ngw) {
        const int iblk = item & 127, h = (item >> 7) % 24, b = item / (128 * 24), grp = h >> 3, ld = 2 * grp, d = 1 << ld, Lg = SEQ >> ld;
        const int i0 = iblk * 32, r = i0 / Lg, m0 = i0 % Lg;
#pragma unroll
        for (int s = 0; s < 8; ++s) { const int pi = 4 * s + (lane >> 4); const int pos = (m0 + pi) * d + r;
            const v4u x = *(const v4u*)(VF + (size_t)(b * SEQ + pos) * MIXW + h * 128 + 8 * (lane & 15));
            *(LAS v4u*)(T + pi * PITCH + 16 * (lane & 15)) = x; }
        LDS_WAIT(); asm volatile("" ::: "memory");
#pragma unroll
        for (int s = 0; s < 8; ++s) { const int dim = (s & 1) * 64 + lane, gq = s >> 1;
            unsigned short e[8];
#pragma unroll
            for (int k = 0; k < 8; ++k) e[k] = *(const LAS unsigned short*)(T + (8 * gq + k) * PITCH + dim * 2);
            v4u o; o.x = (unsigned)e[0] | ((unsigned)e[1] << 16); o.y = (unsigned)e[2] | ((unsigned)e[3] << 16); o.z = (unsigned)e[4] | ((unsigned)e[5] << 16); o.w = (unsigned)e[6] | ((unsigned)e[7] << 16);
            *(v4u*)(VT + (size_t)(b * 24 + h) * (128 * SEQ) + (size_t)((iblk * 8 + (dim >> 4)) * 2 + (gq >> 1)) * 256 + (dim & 15) * 16 + (gq & 1) * 8) = o; }
        LDS_WAIT(); asm volatile("" ::: "memory");
    }
}

__device__ __forceinline__ void attn_mfma(const Ctx& C, const bf16* P, const bf16* KB2, const bf16* VT, bf16* CAT) {
    const int lane = C.lane, c = lane & 15, g = lane >> 4;
    const float sc = 0.08838834764831845f * 1.4426950408889634f;
    for (int U = blockIdx.x; U < 512; U += gridDim.x) {
        const int half = U & 1, chunk = (U >> 1) & 15, j = (U >> 5) & 7, b = U >> 8;
        const int r16 = half * 8 + C.wave, base = chunk * 256, qpos = base + 16 * c + r16;
        float m = -1e30f, l = 0.f; f32x4 o[8];
#pragma unroll
        for (int dt = 0; dt < 8; ++dt) o[dt] = (f32x4){0.f, 0.f, 0.f, 0.f};
#pragma unroll
        for (int grp = 0; grp < 3; ++grp) {
            const int ld = 2 * grp, d = 1 << ld, Lg = SEQ >> ld, h = 8 * grp + j, rg = r16 & (d - 1);
            const int mq = qpos >> ld, lo = (mq - 128 > 0) ? (mq - 128) : 0;
            const int m0 = (base + r16) >> ld, m15 = (base + 240 + r16) >> ld;
            const int kstart = (m0 - 128) & ~31, nsteps = ((m15 - kstart) >> 5) + 1;
            bf16x8v qf[4];
            { const bf16* qp = P + (size_t)(b * SEQ + qpos) * LDP + PA_Q + h * 128 + 8 * g;
#pragma unroll
              for (int ks = 0; ks < 4; ++ks) qf[ks] = *(const bf16x8v*)(qp + 32 * ks); }
            const bf16* kbase = KB2 + (size_t)(b * 24 + h) * (128 * SEQ) + (size_t)(rg * (Lg >> 4)) * 2048 + c * 32 + g * 8;
            const bf16* vbase = VT + (size_t)(b * 24 + h) * (128 * SEQ) + (size_t)(rg * (Lg >> 5)) * 4096 + c * 16 + g * 4;
            bf16x8v kc[8], kn[8];
#define ATT_KLOAD(dst, ss) do { int kt_ = (kstart >> 4) + 2 * (ss); kt_ = kt_ < 0 ? 0 : (kt_ > (Lg >> 4) - 2 ? (Lg >> 4) - 2 : kt_);       \
                const bf16* kp_ = kbase + (size_t)kt_ * 2048; \
                _Pragma("unroll") for (int ks = 0; ks < 4; ++ks) { dst[ks] = *(const bf16x8v*)(kp_ + ks * 512); dst[4 + ks] = *(const bf16x8v*)(kp_ + 2048 + ks * 512); } } while (0)
            v2u x0[8], x1[8], y0[8], y1[8];
#define ATT_VLOAD(d0, d1, ss) do { int kbk_ = (kstart >> 5) + (ss); kbk_ = kbk_ < 0 ? 0 : (kbk_ > (Lg >> 5) - 1 ? (Lg >> 5) - 1 : kbk_);       \
                const bf16* vb_ = vbase + (size_t)kbk_ * 4096; \
                _Pragma("unroll") for (int dt = 0; dt < 8; ++dt) { d0[dt] = *(const v2u*)(vb_ + dt * 512); d1[dt] = *(const v2u*)(vb_ + dt * 512 + 256); } } while (0)
            ATT_KLOAD(kc, 0); ATT_VLOAD(x0, x1, 0);
            for (int s = 0; s < nsteps; ++s) {
                const int kb = kstart + 32 * s;
                const int v4a = kb + 4 * g, v4b = kb + 16 + 4 * g;
                ATT_KLOAD(kn, s + 1); ATT_VLOAD(y0, y1, s + 1);
                f32x4 s0 = (f32x4){0.f, 0.f, 0.f, 0.f}, s1 = (f32x4){0.f, 0.f, 0.f, 0.f};
#pragma unroll
                for (int ks = 0; ks < 4; ++ks) { s0 = __builtin_amdgcn_mfma_f32_16x16x32_bf16(kc[ks], qf[ks], s0, 0, 0, 0); s1 = __builtin_amdgcn_mfma_f32_16x16x32_bf16(kc[4 + ks], qf[ks], s1, 0, 0, 0); }
                float t[8]; bool ok[8]; float mx = -1e30f;
#pragma unroll
                for (int r = 0; r < 4; ++r) { const int k0i = v4a + r, k1i = v4b + r; ok[r] = (k0i >= lo) && (k0i <= mq); ok[4 + r] = (k1i >= lo) && (k1i <= mq);
                    t[r] = s0[r] * sc; t[4 + r] = s1[r] * sc; if (ok[r]) mx = fmaxf(mx, t[r]); if (ok[4 + r]) mx = fmaxf(mx, t[4 + r]); }
                mx = fmaxf(mx, __shfl_xor(mx, 16)); mx = fmaxf(mx, __shfl_xor(mx, 32));
                const float mn = fmaxf(m, mx), alpha = __builtin_amdgcn_exp2f(m - mn); m = mn;
                float p[8], ps = 0.f;
#pragma unroll
                for (int r = 0; r < 8; ++r) { p[r] = ok[r] ? __builtin_amdgcn_exp2f(t[r] - mn) : 0.f; ps += p[r]; }
                l = l * alpha + ps;
#pragma unroll
                for (int dt = 0; dt < 8; ++dt) o[dt] = o[dt] * alpha;
                v4u pw; pw.x = pk2(p[0], p[1]); pw.y = pk2(p[2], p[3]); pw.z = pk2(p[4], p[5]); pw.w = pk2(p[6], p[7]);
                const bf16x8v pf = __builtin_bit_cast(bf16x8v, pw);
#pragma unroll
                for (int dt = 0; dt < 8; ++dt) { v4u vw; vw.x = x0[dt].x; vw.y = x0[dt].y; vw.z = x1[dt].x; vw.w = x1[dt].y;
                    o[dt] = __builtin_amdgcn_mfma_f32_16x16x32_bf16(__builtin_bit_cast(bf16x8v, vw), pf, o[dt], 0, 0, 0); }
#pragma unroll
                for (int i = 0; i < 8; ++i) { kc[i] = kn[i]; x0[i] = y0[i]; x1[i] = y1[i]; }
            }
#undef ATT_KLOAD
#undef ATT_VLOAD
        }
        l += __shfl_xor(l, 16); l += __shfl_xor(l, 32);
        const float inv = 1.f / l;
        bf16* op = CAT + (size_t)(b * SEQ + qpos) * A_CAT + j * 128 + 4 * g;
#pragma unroll
        for (int dt = 0; dt < 8; ++dt) { v2u ow; ow.x = pk2(o[dt][0] * inv, o[dt][1] * inv); ow.y = pk2(o[dt][2] * inv, o[dt][3] * inv); *(v2u*)(op + dt * 16) = ow; }
    }
}

namespace pg8 {
struct EpiConvAct {
    static constexpr bool PERM = true, AFTER_DRAIN = false;
    bf16_t* ACT; float* HALO; float* RAWG; float* RAWU; const float* cw; const float* cb;
    __device__ __forceinline__ void operator()(const f32x4 (&acc)[2][2][4][2], const Unit& u, int, int, int, int) const {
        int t_ = threadIdx.x; asm volatile("" : "+v"(t_)); const int wid_ = __builtin_amdgcn_readfirstlane(t_ >> 6), wr = wid_ >> 2, wc = wid_ & 3, fr = t_ & 15, fq = (t_ >> 4) & 3;
        const int c0 = u.pn * HALF + wc * 32 + 8 * fq;
#pragma unroll
        for (int ai = 0; ai < 2; ++ai) {
            const int rb = u.pm * 4 + ai * 2 + wr;
            const int row0 = rb * 64 + fr;
            unsigned pk0[4][2];
#pragma unroll
            for (int n = 0; n < 2; ++n) {
                const f32x4 w0 = *(const f32x4*)(cw + c0 + 4 * n), w1 = *(const f32x4*)(cw + DFF + c0 + 4 * n), w2 = *(const f32x4*)(cw + 2 * DFF + c0 + 4 * n), bb = *(const f32x4*)(cb + c0 + 4 * n);
                float o[4][4];
#pragma unroll
                for (int e = 0; e < 4; ++e) { float g[4], r1[4], r2[4];
#pragma unroll
                    for (int m = 0; m < 4; ++m) { g[m] = acc[ai][0][m][n][e]; r1[m] = dppf<0x121>(g[m]); r2[m] = dppf<0x122>(g[m]); }
#pragma unroll
                    for (int m = 0; m < 4; ++m) { const float p1 = (m > 0 && fr == 0) ? r1[m > 0 ? m - 1 : 0] : r1[m], p2 = (m > 0 && fr < 2) ? r2[m > 0 ? m - 1 : 0] : r2[m];
                        const float gt = bb[e] + w0[e] * p2 + w1[e] * p1 + w2[e] * g[m];
                        o[m][e] = gt * __builtin_amdgcn_rcpf(1.f + __expf(-gt)) * acc[ai][1][m][n][e]; } }
#pragma unroll
                for (int m = 0; m < 4; ++m) { const unsigned wx = cvt_pk_bf16(o[m][0], o[m][1]), wy = cvt_pk_bf16(o[m][2], o[m][3]);
                    if (n == 0) { pk0[m][0] = wx; pk0[m][1] = wy; }
                    else if (m > 0 || fr >= 2) { u32x4 w; w.x = pk0[m][0]; w.y = pk0[m][1]; w.z = wx; w.w = wy; *(u32x4*)(ACT + (size_t)(row0 + 16 * m) * DFF + c0) = w; } }
                asm volatile("" ::: "memory");
            }
            if (fr < 2) { float* pg = RAWG + ((size_t)rb * 2 + fr) * DFF + c0; float* pu = RAWU + ((size_t)rb * 2 + fr) * DFF + c0;
                *(f32x4*)pg = acc[ai][0][0][0]; *(f32x4*)(pg + 4) = acc[ai][0][0][1]; *(f32x4*)pu = acc[ai][1][0][0]; *(f32x4*)(pu + 4) = acc[ai][1][0][1]; }
            if (fr >= 14) { float* ph = HALO + ((size_t)rb * 2 + (fr - 14)) * DFF + c0; *(f32x4*)ph = acc[ai][0][3][0]; *(f32x4*)(ph + 4) = acc[ai][0][3][1]; }
            asm volatile("" ::: "memory");
        }
    }
};
}
__device__ __forceinline__ void convact_fixup(const Ctx& C, const float* HALO, const float* RAWG, const float* RAWU, const float* cw, const float* cb, bf16* ACT) {
    for (int idx = C.gtid; idx < 128 * 2 * (DFF / 4); idx += C.GT) { const int c4 = idx % (DFF / 4), rr = (idx / (DFF / 4)) & 1, rb = idx / (2 * (DFF / 4)), c = 4 * c4;
        const f32x4 g0 = *(const f32x4*)(RAWG + ((size_t)rb * 2 + rr) * DFF + c), uu = *(const f32x4*)(RAWU + ((size_t)rb * 2 + rr) * DFF + c);
        f32x4 gm1 = (f32x4){0.f, 0.f, 0.f, 0.f}, gm2 = (f32x4){0.f, 0.f, 0.f, 0.f};
        const bool has_prev = (rb & 63) != 0;
        if (rr == 0) { if (has_prev) { gm1 = *(const f32x4*)(HALO + ((size_t)(rb - 1) * 2 + 1) * DFF + c); gm2 = *(const f32x4*)(HALO + ((size_t)(rb - 1) * 2 + 0) * DFF + c); } }
        else { gm1 = *(const f32x4*)(RAWG + ((size_t)rb * 2 + 0) * DFF + c); if (has_prev) gm2 = *(const f32x4*)(HALO + ((size_t)(rb - 1) * 2 + 1) * DFF + c); }
        const f32x4 a0 = *(const f32x4*)(cw + c), a1 = *(const f32x4*)(cw + DFF + c), a2 = *(const f32x4*)(cw + 2 * DFF + c), b0 = *(const f32x4*)(cb + c);
        float r[4];
#pragma unroll
        for (int e = 0; e < 4; ++e) { const float gt = b0[e] + a0[e] * gm2[e] + a1[e] * gm1[e] + a2[e] * g0[e]; r[e] = gt * __builtin_amdgcn_rcpf(1.f + __expf(-gt)) * uu[e]; }
        v2u w; w.x = pk2(r[0], r[1]); w.y = pk2(r[2], r[3]);
        *(v2u*)(ACT + (size_t)(rb * 64 + rr) * DFF + c) = w; }
}

constexpr int CH_REC = 15360, CH_G = 12608, CH_AT = 0, CH_RT = 2048, CH_BK = 4096, CH_VT = 8192, CH_NN = 10240, CH_MAK = 11264, CH_TT = 11776, CH_PC = 12288, CH_BON = 12544;
__device__ __forceinline__ void scan_pre(const Ctx& C, const bf16* P, const float* mu, const float* k_k, const float* k_a, const float* r_k,
                                         const bf16* SW, const bf16* SA, const bf16* SV, const bf16* GG, unsigned char* CH) {
    const int lane = C.lane, tl = lane & 15, g = lane >> 4;
    LAS unsigned char* L = C.lds + RING_OFF + C.wave * 16384;
    LAS unsigned short* LAt = (LAS unsigned short*)L; LAS unsigned short* LRt = LAt + 1024; LAS unsigned short* LBt = LAt + 2048; LAS unsigned short* LKt = LAt + 3072;
    LAS float* Mf = (LAS float*)(L + 8192);
    for (int item = C.gw; item < BATCH * RH * 256; item += C.NGW) {
        const int c = item & 255, bh = item >> 8, b = bh / RH, hh = bh % RH, cj = hh * 64 + lane;
        const float mur = mu[PB_R + cj], muk = mu[PB_K + cj], kkj = k_k[cj], kaj = k_a[cj], rkj = r_k[cj];
        unsigned char* rec = CH + (size_t)item * CH_REC;
        float rr[16], k2[16], aa[16], bb[16], ww[16]; unsigned vv[16], gg_[16]; float bon = 0.f;
#pragma unroll
        for (int t = 0; t < 16; ++t) { const int tt = 16 * c + t; const size_t row = (size_t)b * SEQ + tt;
            const bf16* pp = P + row * LDP + cj; const bf16* pq = (tt > 0) ? (pp - LDP) : pp;
            const unsigned pr = pp[PB_R], pk = pp[PB_K], pr1 = pq[PB_R], pk1 = pq[PB_K];
            const size_t o = row * MIXW + cj; const float as = bf2f(SA[o]); ww[t] = bf2f(SW[o]); vv[t] = SV[o]; gg_[t] = GG[o];
            const float rc = bflo(pr), kc = bflo(pk), rp = (tt > 0) ? bflo(pr1) : 0.f, kp = (tt > 0) ? bflo(pk1) : 0.f;
            const float r = rc + (rp - rc) * mur, k = kc + (kp - kc) * muk;
            float kk = k * kkj; const float nrm = sqrtf(wave_sum_dpp(kk * kk)); kk = kk / fmaxf(nrm, 1e-12f);
            rr[t] = r; aa[t] = -kk; bb[t] = kk * as; k2[t] = k * (1.f + (as - 1.f) * kaj);
            const float bt = wave_sum_dpp(r * k2[t] * rkj); if (lane == t) bon = bt; }
        float p = 1.f, cs_ = 0.f, ip[16];
#pragma unroll
        for (int t = 0; t < 16; ++t) { const float pm1 = p; cs_ += ww[t]; p = __expf(cs_); ip[t] = __expf(-cs_);
            LAt[t * 64 + lane] = (unsigned short)f2bf(aa[t] * pm1); LRt[t * 64 + lane] = (unsigned short)f2bf(rr[t] * p);
            LBt[t * 64 + lane] = (unsigned short)f2bf(bb[t] * ip[t]); LKt[t * 64 + lane] = (unsigned short)f2bf(k2[t] * ip[t]); }
#pragma unroll
        for (int gg = 0; gg < 4; ++gg) { v4u o;
            o.x = pk2(bb[4 * gg] * ip[4 * gg] * p, bb[4 * gg + 1] * ip[4 * gg + 1] * p); o.y = pk2(bb[4 * gg + 2] * ip[4 * gg + 2] * p, bb[4 * gg + 3] * ip[4 * gg + 3] * p);
            o.z = pk2(k2[4 * gg] * ip[4 * gg] * p, k2[4 * gg + 1] * ip[4 * gg + 1] * p); o.w = pk2(k2[4 * gg + 2] * ip[4 * gg + 2] * p, k2[4 * gg + 3] * ip[4 * gg + 3] * p);
            *(v4u*)(rec + CH_BK + (lane * 4 + gg) * 16) = o; }
        *(float*)(rec + CH_PC + lane * 4) = p;
#define PKB(a, b) ((a) | ((b) << 16))
        { v4u o0, o1; o0.x = PKB(vv[0], vv[1]); o0.y = PKB(vv[2], vv[3]); o0.z = PKB(vv[4], vv[5]); o0.w = PKB(vv[6], vv[7]); o1.x = PKB(vv[8], vv[9]); o1.y = PKB(vv[10], vv[11]); o1.z = PKB(vv[12], vv[13]); o1.w = PKB(vv[14], vv[15]);
          *(v4u*)(rec + CH_VT + lane * 32) = o0; *(v4u*)(rec + CH_VT + lane * 32 + 16) = o1; }
        { v4u o0, o1; o0.x = PKB(gg_[0], gg_[1]); o0.y = PKB(gg_[2], gg_[3]); o0.z = PKB(gg_[4], gg_[5]); o0.w = PKB(gg_[6], gg_[7]); o1.x = PKB(gg_[8], gg_[9]); o1.y = PKB(gg_[10], gg_[11]); o1.z = PKB(gg_[12], gg_[13]); o1.w = PKB(gg_[14], gg_[15]);
          *(v4u*)(rec + CH_G + lane * 32) = o0; *(v4u*)(rec + CH_G + lane * 32 + 16) = o1; }
        if (lane < 16) *(float*)(rec + CH_BON + lane * 4) = bon;
        LDS_WAIT(); asm volatile("" ::: "memory");
#pragma unroll
        for (int ks = 0; ks < 2; ++ks) { const int j0 = tl * 64 + 32 * ks + 4 * g;
            const v2u a0 = *(const LAS v2u*)(LAt + j0), a1 = *(const LAS v2u*)(LAt + j0 + 16), r0 = *(const LAS v2u*)(LRt + j0), r1 = *(const LAS v2u*)(LRt + j0 + 16);
            v4u oa, orr; oa.x = a0.x; oa.y = a0.y; oa.z = a1.x; oa.w = a1.y; orr.x = r0.x; orr.y = r0.y; orr.z = r1.x; orr.w = r1.y;
            *(v4u*)(rec + CH_AT + tl * 128 + (32 * ks + 8 * g) * 2) = oa; *(v4u*)(rec + CH_RT + tl * 128 + (32 * ks + 8 * g) * 2) = orr; }
        f32x4 mab = (f32x4){0.f, 0.f, 0.f, 0.f}, mak = mab, nbr = mab, nkr = mab;
#pragma unroll
        for (int ks = 0; ks < 2; ++ks) { const int fo = tl * 64 + 32 * ks + 8 * g;
            const bf16x8v fb = *(const LAS bf16x8v*)(LBt + fo), fk = *(const LAS bf16x8v*)(LKt + fo), fa = *(const LAS bf16x8v*)(LAt + fo), fr_ = *(const LAS bf16x8v*)(LRt + fo);
            mab = __builtin_amdgcn_mfma_f32_16x16x32_bf16(fb, fa, mab, 0, 0, 0); mak = __builtin_amdgcn_mfma_f32_16x16x32_bf16(fk, fa, mak, 0, 0, 0);
            nbr = __builtin_amdgcn_mfma_f32_16x16x32_bf16(fb, fr_, nbr, 0, 0, 0); nkr = __builtin_amdgcn_mfma_f32_16x16x32_bf16(fk, fr_, nkr, 0, 0, 0); }
#pragma unroll
        for (int e = 0; e < 4; ++e) { const int s = 4 * g + e; if (!(s < tl)) { mab[e] = 0.f; mak[e] = 0.f; } if (!(s <= tl)) { nbr[e] = 0.f; nkr[e] = 0.f; } Mf[s * 16 + tl] = mab[e]; }
        { v2u o; o.x = pk2(mak[0], mak[1]); o.y = pk2(mak[2], mak[3]); *(v2u*)(rec + CH_MAK + (tl * 16 + 4 * g) * 2) = o;
          v4u n; n.x = pk2(nbr[0], nbr[1]); n.y = pk2(nbr[2], nbr[3]); n.z = pk2(nkr[0], nkr[1]); n.w = pk2(nkr[2], nkr[3]); *(v4u*)(rec + CH_NN + (tl * 4 + g) * 16) = n; }
        LDS_WAIT(); asm volatile("" ::: "memory");
        float Tc[16];
#pragma unroll
        for (int s = 15; s >= 0; --s) { float acc_ = (s == tl) ? 1.f : 0.f;
#pragma unroll
            for (int q = s + 1; q < 16; ++q) acc_ += Mf[s * 16 + q] * Tc[q];
            Tc[s] = acc_; }
        if (g == 0) { v4u o0, o1; o0.x = pk2(Tc[0], Tc[1]); o0.y = pk2(Tc[2], Tc[3]); o0.z = pk2(Tc[4], Tc[5]); o0.w = pk2(Tc[6], Tc[7]); o1.x = pk2(Tc[8], Tc[9]); o1.y = pk2(Tc[10], Tc[11]); o1.z = pk2(Tc[12], Tc[13]); o1.w = pk2(Tc[14], Tc[15]);
            *(v4u*)(rec + CH_TT + tl * 32) = o0; *(v4u*)(rec + CH_TT + tl * 32 + 16) = o1; }
        LDS_WAIT(); asm volatile("" ::: "memory");
    }
}

constexpr int YB_PITCH = 20;


constexpr int SQ_D = 7, SQ_AHEAD = SQ_D - 2, SQ_SLOT = CH_REC, YT_PITCH = 68;
__device__ __forceinline__ void scan_seq2(const Ctx& C, const unsigned char* CH, const float* ln_g, const float* ln_b, bf16* CAT) {
    const int bh = blockIdx.x; if (bh >= BATCH * RH) return;
    const int b = bh / RH, hh = bh % RH, lane = C.lane, w = C.wave, tl = lane & 15, g = lane >> 4;
    LAS unsigned char* ring = C.lds + RING_OFF;
    LAS float* Yb = (LAS float*)(C.lds + RING_OFF + SQ_D * SQ_SLOT);
    const unsigned char* rec0 = CH + (size_t)bh * 256 * CH_REC;
#define SQ_BAR() do { asm volatile("s_waitcnt lgkmcnt(0)" ::: "memory"); __builtin_amdgcn_s_barrier(); asm volatile("" ::: "memory"); } while (0)
    if (w < 4) {
        int pcs[4];
#pragma unroll
        for (int i = 0; i < 4; ++i) { int pidx = 4 * w + i; pcs[i] = (pidx > 14 ? 14 : pidx) * 1024; }
#define SQ_ISSUE(cc) do { const unsigned char* src = rec0 + (size_t)(cc) * CH_REC + lane * 16; LAS unsigned char* dst = ring + ((cc) % SQ_D) * SQ_SLOT; \
            _Pragma("unroll") for (int i = 0; i < 4; ++i) __builtin_amdgcn_global_load_lds((const unsigned*)(src + pcs[i]), (LAS unsigned*)(dst + pcs[i]), 16, 0, 0); } while (0)
#pragma unroll
        for (int cc = 0; cc < SQ_AHEAD; ++cc) SQ_ISSUE(cc);
        f32x4 S[4];
#pragma unroll
        for (int jt = 0; jt < 4; ++jt) S[jt] = (f32x4){0.f, 0.f, 0.f, 0.f};
        const int icol = 16 * w + tl;
        for (int c = 0; c < 256; ++c) {
            if (c + SQ_AHEAD - 1 < 256) asm volatile("s_waitcnt vmcnt(16)" ::: "memory");
            else asm volatile("s_waitcnt vmcnt(0)" ::: "memory");
            SQ_BAR();
            if (c + SQ_AHEAD < 256) SQ_ISSUE(c + SQ_AHEAD);
            const LAS unsigned char* rec = ring + (c % SQ_D) * SQ_SLOT;
            const bf16x8v cAt0 = *(const LAS bf16x8v*)(rec + CH_AT + tl * 128 + (8 * g) * 2), cAt1 = *(const LAS bf16x8v*)(rec + CH_AT + tl * 128 + (32 + 8 * g) * 2);
            const bf16x8v cRt0 = *(const LAS bf16x8v*)(rec + CH_RT + tl * 128 + (8 * g) * 2), cRt1 = *(const LAS bf16x8v*)(rec + CH_RT + tl * 128 + (32 + 8 * g) * 2);
            const bf16x8v cBK0 = *(const LAS bf16x8v*)(rec + CH_BK + ((tl) * 4 + g) * 16), cBK1 = *(const LAS bf16x8v*)(rec + CH_BK + ((16 + tl) * 4 + g) * 16);
            const bf16x8v cBK2 = *(const LAS bf16x8v*)(rec + CH_BK + ((32 + tl) * 4 + g) * 16), cBK3 = *(const LAS bf16x8v*)(rec + CH_BK + ((48 + tl) * 4 + g) * 16);
            const f32x4 cp0 = *(const LAS f32x4*)(rec + CH_PC + (4 * g) * 4), cp1 = *(const LAS f32x4*)(rec + CH_PC + (16 + 4 * g) * 4), cp2 = *(const LAS f32x4*)(rec + CH_PC + (32 + 4 * g) * 4), cp3 = *(const LAS f32x4*)(rec + CH_PC + (48 + 4 * g) * 4);
            const bf16x8v cN = *(const LAS bf16x8v*)(rec + CH_NN + (tl * 4 + g) * 16);
            const v2u cMak = *(const LAS v2u*)(rec + CH_MAK + (tl * 16 + 4 * g) * 2), cT = *(const LAS v2u*)(rec + CH_TT + (tl * 16 + 4 * g) * 2), cV = *(const LAS v2u*)(rec + CH_VT + (icol * 16 + 4 * g) * 2);
            v4u t4; bf16x8v sb0, sb1;
            t4.x = pk2(S[0][0], S[0][1]); t4.y = pk2(S[0][2], S[0][3]); t4.z = pk2(S[1][0], S[1][1]); t4.w = pk2(S[1][2], S[1][3]); sb0 = __builtin_bit_cast(bf16x8v, t4);
            t4.x = pk2(S[2][0], S[2][1]); t4.y = pk2(S[2][2], S[2][3]); t4.z = pk2(S[3][0], S[3][1]); t4.w = pk2(S[3][2], S[3][3]); sb1 = __builtin_bit_cast(bf16x8v, t4);
            t4.x = cMak.x; t4.y = cMak.y; t4.z = 0u; t4.w = 0u; const bf16x8v fMak = __builtin_bit_cast(bf16x8v, t4);
            t4.x = cV.x; t4.y = cV.y; t4.z = 0u; t4.w = 0u; const bf16x8v fV0 = __builtin_bit_cast(bf16x8v, t4);
            t4.x = cT.x; t4.y = cT.y; t4.z = 0u; t4.w = 0u; const bf16x8v fT = __builtin_bit_cast(bf16x8v, t4);
            f32x4 Z = (f32x4){0.f, 0.f, 0.f, 0.f};
            Z = __builtin_amdgcn_mfma_f32_16x16x32_bf16(fMak, fV0, Z, 0, 0, 0);
            Z = __builtin_amdgcn_mfma_f32_16x16x32_bf16(cAt0, sb0, Z, 0, 0, 0);
            Z = __builtin_amdgcn_mfma_f32_16x16x32_bf16(cAt1, sb1, Z, 0, 0, 0);
            f32x4 Y = (f32x4){0.f, 0.f, 0.f, 0.f};
            Y = __builtin_amdgcn_mfma_f32_16x16x32_bf16(cRt0, sb0, Y, 0, 0, 0);
            Y = __builtin_amdgcn_mfma_f32_16x16x32_bf16(cRt1, sb1, Y, 0, 0, 0);
            t4.x = pk2(Z[0], Z[1]); t4.y = pk2(Z[2], Z[3]); t4.z = 0u; t4.w = 0u;
            f32x4 U = (f32x4){0.f, 0.f, 0.f, 0.f};
            U = __builtin_amdgcn_mfma_f32_16x16x32_bf16(fT, __builtin_bit_cast(bf16x8v, t4), U, 0, 0, 0);
            t4.x = pk2(U[0], U[1]); t4.y = pk2(U[2], U[3]); t4.z = cV.x; t4.w = cV.y; const bf16x8v buv = __builtin_bit_cast(bf16x8v, t4);
            S[0] = S[0] * cp0; S[1] = S[1] * cp1; S[2] = S[2] * cp2; S[3] = S[3] * cp3;
            S[0] = __builtin_amdgcn_mfma_f32_16x16x32_bf16(cBK0, buv, S[0], 0, 0, 0); S[1] = __builtin_amdgcn_mfma_f32_16x16x32_bf16(cBK1, buv, S[1], 0, 0, 0);
            S[2] = __builtin_amdgcn_mfma_f32_16x16x32_bf16(cBK2, buv, S[2], 0, 0, 0); S[3] = __builtin_amdgcn_mfma_f32_16x16x32_bf16(cBK3, buv, S[3], 0, 0, 0);
            Y = __builtin_amdgcn_mfma_f32_16x16x32_bf16(cN, buv, Y, 0, 0, 0);
#pragma unroll
            for (int e = 0; e < 4; ++e) Yb[(c & 1) * 16 * YT_PITCH + (4 * g + e) * YT_PITCH + icol] = Y[e];
        }
        SQ_BAR();
#undef SQ_ISSUE
    } else {
        const int pw = w - 4, tq = lane >> 4, iq = lane & 15, tt = 4 * pw + tq, cj = hh * 64 + 4 * iq;
        const f32x4 lng = *(const f32x4*)(ln_g + cj), lnb = *(const f32x4*)(ln_b + cj);
        for (int c = 0; c <= 256; ++c) {
            SQ_BAR();
            if (c > 0) { const LAS unsigned char* rec = ring + ((c - 1) % SQ_D) * SQ_SLOT;
                const f32x4 y4 = *(const LAS f32x4*)(Yb + ((c - 1) & 1) * 16 * YT_PITCH + tt * YT_PITCH + 4 * iq);
                const float bo = *(const LAS float*)(rec + CH_BON + tt * 4);
                float vv[4], gv[4];
#pragma unroll
                for (int e = 0; e < 4; ++e) { vv[e] = bf2f(*(const LAS unsigned short*)(rec + CH_VT + ((4 * iq + e) * 16 + tt) * 2)); gv[e] = bf2f(*(const LAS unsigned short*)(rec + CH_G + ((4 * iq + e) * 16 + tt) * 2)); }
                const float s1 = row16_sum((y4[0] + y4[1]) + (y4[2] + y4[3])), s2 = row16_sum((y4[0] * y4[0] + y4[1] * y4[1]) + (y4[2] * y4[2] + y4[3] * y4[3]));
                const float mean = s1 * (1.f / 64.f), var = fmaxf(s2 * (1.f / 64.f) - mean * mean, 0.f), rstd = __builtin_amdgcn_rsqf(var + GN_EPS);
                float o[4];
#pragma unroll
                for (int e = 0; e < 4; ++e) o[e] = ((y4[e] - mean) * rstd * lng[e] + lnb[e] + bo * vv[e]) * gv[e];
                const size_t row = (size_t)b * SEQ + 16 * (c - 1) + tt;
                v2u ow; ow.x = pk2(o[0], o[1]); ow.y = pk2(o[2], o[3]); *(v2u*)(CAT + row * DM + cj) = ow; }
        }
    }
#undef SQ_BAR
}

__device__ __forceinline__ void xattn_lds(const Ctx& C, const bf16* P, int cqoff, const bf16* MEMKV, const bf16* MEMVT, bf16* CAT, int ldc, int catoff, int u0, int ustride) {
    constexpr int KP = 528, VP = 272;
    const int lane = C.lane, w = C.wave, c = lane & 15, g = lane >> 4, tid = C.tid;
    LAS unsigned char* Ls = C.lds + RING_OFF;
    for (int u = u0; u < 256; u += ustride) {
        const int b = u >> 7, xh = (u >> 5) & 3, qb = u & 31;
        const int qrow = b * SEQ + qb * 128 + w * 16 + c;
        bf16x8v qf[8];
        { const bf16* qp = P + (size_t)qrow * LDP + cqoff + xh * 256 + 8 * g;
#pragma unroll
          for (int ks = 0; ks < 8; ++ks) qf[ks] = *(const bf16x8v*)(qp + 32 * ks); }
        f32x4 s[16];
#pragma unroll
        for (int kt = 0; kt < 16; ++kt) s[kt] = (f32x4){0.f, 0.f, 0.f, 0.f};
#pragma unroll
        for (int half = 0; half < 2; ++half) {
            v4u stg[8];
#pragma unroll
            for (int it = 0; it < 8; ++it) { const int idx = it * 512 + tid, row = idx >> 5, c16 = idx & 31;
                stg[it] = *(const v4u*)(MEMKV + (size_t)(b * 256 + half * 128 + row) * 2048 + xh * 256 + c16 * 8); }
            __syncthreads();
#pragma unroll
            for (int it = 0; it < 8; ++it) { const int idx = it * 512 + tid, row = idx >> 5, c16 = idx & 31; *(LAS v4u*)(Ls + row * KP + c16 * 16) = stg[it]; }
            __syncthreads();
#pragma unroll
            for (int kt = 0; kt < 8; ++kt) {
#pragma unroll
                for (int ks = 0; ks < 8; ++ks) { const bf16x8v kf = *(const LAS bf16x8v*)(Ls + (16 * kt + c) * KP + (32 * ks + 8 * g) * 2);
                    s[8 * half + kt] = __builtin_amdgcn_mfma_f32_16x16x32_bf16(kf, qf[ks], s[8 * half + kt], 0, 0, 0); }
                asm volatile("" ::: "memory"); }
        }
        float m = -1e30f;
#pragma unroll
        for (int kt = 0; kt < 16; ++kt) m = fmaxf(fmaxf(m, fmaxf(s[kt][0], s[kt][1])), fmaxf(s[kt][2], s[kt][3]));
        m = fmaxf(m, __shfl_xor(m, 16)); m = fmaxf(m, __shfl_xor(m, 32));
        float l = 0.f; const float sc = 0.0625f * 1.4426950408889634f;
        bf16x8v pf[8];
#pragma unroll
        for (int kk = 0; kk < 8; ++kk) { float p[8];
#pragma unroll
            for (int r = 0; r < 4; ++r) { p[r] = __builtin_amdgcn_exp2f((s[2 * kk][r] - m) * sc); p[4 + r] = __builtin_amdgcn_exp2f((s[2 * kk + 1][r] - m) * sc); }
#pragma unroll
            for (int r = 0; r < 8; ++r) l += p[r];
            v4u pw; pw.x = pk2(p[0], p[1]); pw.y = pk2(p[2], p[3]); pw.z = pk2(p[4], p[5]); pw.w = pk2(p[6], p[7]);
            pf[kk] = __builtin_bit_cast(bf16x8v, pw); }
        l += __shfl_xor(l, 16); l += __shfl_xor(l, 32);
        const float inv = 1.f / l;
        f32x4 o[16];
#pragma unroll
        for (int dt = 0; dt < 16; ++dt) o[dt] = (f32x4){0.f, 0.f, 0.f, 0.f};
#pragma unroll
        for (int half = 0; half < 2; ++half) {
            v4u stg[8];
#pragma unroll
            for (int it = 0; it < 8; ++it) { const int idx = it * 512 + tid, key = idx >> 5, d8 = idx & 31;
                stg[it] = *(const v4u*)(MEMKV + (size_t)(b * 256 + half * 128 + key) * 2048 + 1024 + xh * 256 + d8 * 8); }
            __syncthreads();
#pragma unroll
            for (int it = 0; it < 8; ++it) { const int idx = it * 512 + tid, key = idx >> 5, d8 = idx & 31;
#pragma unroll
                for (int e = 0; e < 8; ++e) { const unsigned wv = stg[it][e >> 1]; *(LAS unsigned short*)(Ls + (8 * d8 + e) * VP + key * 2) = (unsigned short)((e & 1) ? (wv >> 16) : (wv & 0xffffu)); } }
            __syncthreads();
#pragma unroll
            for (int dt = 0; dt < 16; ++dt) {
#pragma unroll
                for (int kk = 0; kk < 4; ++kk) { const LAS unsigned char* vp = Ls + (16 * dt + c) * VP + (32 * kk + 4 * g) * 2;
                    const v2u lo = *(const LAS v2u*)vp, hi = *(const LAS v2u*)(vp + 32);
                    v4u vw; vw.x = lo.x; vw.y = lo.y; vw.z = hi.x; vw.w = hi.y;
                    o[dt] = __builtin_amdgcn_mfma_f32_16x16x32_bf16(__builtin_bit_cast(bf16x8v, vw), pf[4 * half + kk], o[dt], 0, 0, 0); }
                if (dt & 1) asm volatile("" ::: "memory"); }
        }
        bf16* op = CAT + (size_t)qrow * ldc + catoff + xh * 256 + 4 * g;
#pragma unroll
        for (int dt = 0; dt < 16; ++dt) { v2u ow; ow.x = pk2(o[dt][0] * inv, o[dt][1] * inv); ow.y = pk2(o[dt][2] * inv, o[dt][3] * inv); *(v2u*)(op + dt * 16) = ow; }
    }
}

namespace pg8 {
struct EpiAin {
    static constexpr bool PERM = true, AFTER_DRAIN = false;
    bf16_t* P; bf16_t* VF; const float* ROPE; bf16_t* KB2;
    __device__ __forceinline__ void operator()(const f32x4 (&acc)[2][2][4][2], const Unit& u, int, int, int, int) const {
        int t_ = threadIdx.x; asm volatile("" : "+v"(t_)); const int wid_ = __builtin_amdgcn_readfirstlane(t_ >> 6), wr = wid_ >> 2, wc = wid_ & 3, fr = t_ & 15, fq = (t_ >> 4) & 3;
        const int row0 = u.pm * BM + wr * 64 + fr; const int colt = u.pn * BM + wc * 32 + 8 * fq;
        const bool is_v = (u.pn >= 24 && u.pn < 36), is_k = (u.pn >= 12 && u.pn < 24), rot = (u.pn < 24) && (wc == 0);
        bf16_t* base = is_v ? (VF + (colt - PA_V)) : (P + colt); const int ldo = is_v ? MIXW : LDP;
#pragma unroll
        for (int ai = 0; ai < 2; ++ai)
#pragma unroll
            for (int m = 0; m < 4; ++m) { const int row = row0 + ai * HALF + m * 16;
                f32x4 cs[4];
                if (rot) { const float* tp = ROPE + ((size_t)row * 16 + 8 * (fq & 1)) * 2;
#pragma unroll
                    for (int q4 = 0; q4 < 4; ++q4) cs[q4] = *(const f32x4*)(tp + 4 * q4); }
#pragma unroll
                for (int bj = 0; bj < 2; ++bj) { f32x4 v0 = acc[ai][bj][m][0], v1 = acc[ai][bj][m][1];
                    if (rot) { float x[8] = {v0[0], v0[1], v0[2], v0[3], v1[0], v1[1], v1[2], v1[3]};
#pragma unroll
                        for (int e = 0; e < 8; ++e) { const float other = __shfl_xor(x[e], 32); const float cc = cs[e >> 1][2 * (e & 1)], ss = cs[e >> 1][2 * (e & 1) + 1];
                            x[e] = (fq < 2) ? (x[e] * cc - other * ss) : (x[e] * cc + other * ss); }
                        v0 = (f32x4){x[0], x[1], x[2], x[3]}; v1 = (f32x4){x[4], x[5], x[6], x[7]}; }
                    u32x4 w; w.x = cvt_pk_bf16(v0[0], v0[1]); w.y = cvt_pk_bf16(v0[2], v0[3]); w.z = cvt_pk_bf16(v1[0], v1[1]); w.w = cvt_pk_bf16(v1[2], v1[3]);
                    if (is_k) { const int hk = (u.pn - 12) * 2 + bj, ldk_ = 2 * (hk >> 3), tt = row & (SEQ - 1), idx = (tt & ((1 << ldk_) - 1)) * (SEQ >> ldk_) + (tt >> ldk_);
                        *(u32x4*)(KB2 + (size_t)((row >> 12) * 24 + hk) * (128 * SEQ) + (size_t)(idx >> 4) * 2048 + wc * 512 + (idx & 15) * 32 + fq * 8) = w; }
                    else *(u32x4*)(base + (size_t)row * ldo + bj * HALF) = w; }
                asm volatile("" ::: "memory"); }
    }
};
}
constexpr int N_PHASES = 24;
#ifndef REP_CONV
#define REP_CONV 1
#endif
#ifndef REP_ATT
#define REP_ATT 1
#endif
#ifndef REP_SCAN
#define REP_SCAN 1
#endif
#ifndef REP_CACT
#define REP_CACT 1
#endif
#ifndef REP_SONLY
#define REP_SONLY 1
#endif
#ifndef REP_SPRE
#define REP_SPRE 1
#endif
#ifndef REP_LORA
#define REP_LORA 1
#endif
#ifndef REP_UP
#define REP_UP 1
#endif
struct Args { const void* in[30]; float* out; unsigned char* ws; int ph_lo, ph_hi; };
__global__ void __launch_bounds__(NTHREADS, 2) mk_fwd(Args args) {
    extern __shared__ __attribute__((aligned(16))) unsigned char lds_raw[];
    LAS unsigned char* const ldsb = (LAS unsigned char*)lds_raw;
#define MKCTX() Ctx C; { int t_ = threadIdx.x; asm volatile("" : "+v"(t_)); int b_ = blockIdx.x; asm volatile("" : "+s"(b_)); C.lds = ldsb; C.tid = t_; C.lane = t_ & 63; C.wave = __builtin_amdgcn_readfirstlane(t_ >> 6); \
        C.gw = b_ * NWAVES + C.wave; C.NGW = gridDim.x * NWAVES; C.gtid = b_ * NTHREADS + t_; C.GT = gridDim.x * NTHREADS; }
    const int G = gridDim.x, bx = blockIdx.x;
    unsigned char* ws = args.ws;
    gu32* ctl = (gu32*)(ws + WS_CTL);
    volatile LAS unsigned* MISC = (volatile LAS unsigned*)(ldsb + MISC_OFF);
    for (int u = threadIdx.x; u < (LDS_BYTES - LDSCTL_OFF) / 4; u += NTHREADS) ((LAS unsigned*)(ldsb + LDSCTL_OFF))[u] = 0u;
    __syncthreads();
    const int lo = args.ph_lo, hi = args.ph_hi;
    const bool multi = (hi - lo) > 1;
    XcdBarrier bar; bar.bar = (unsigned*)(ctl + CW_BAR); bar.x = 0; bar.st = nullptr;
    if (multi) bar = xcd_barrier_post((unsigned*)(ctl + CW_BAR), MISC + 8);
#ifdef ONLY_PH
#define IN(k) ((k) == ONLY_PH && lo <= (k) && (k) < hi)
#else
#define IN(k) (lo <= (k) && (k) < hi)
#endif
#define SEAM(k) do { if (IN(k) && IN((k) + 1)) xcd_barrier(bar); } while (0)

    constexpr size_t WUP_L = (size_t)DFF2 * DM, WDOWN_L = (size_t)DM * DFF;
#define CAS __attribute__((address_space(4)))
#define KARG_DECL() const CAS char* ka_ = (const CAS char*)__builtin_amdgcn_kernarg_segment_ptr(); asm volatile("" : "+s"(ka_))
#define INF(k) (*(const float* const CAS*)(ka_ + 8 * (k)))
#define WSB(off) ((bf16*)(ws + (off)))
#define WSF(off) ((float*)(ws + (off)))
#define GEMM_BF16(Ap, lda_, Btp, ldb_, M_, N_, K_, Op, ldc_) do { pg8::Gemm g{(const pg8::bf16_t*)(Ap), (const pg8::bf16_t*)(Btp), (M_), (N_), (K_), (lda_), (ldb_)}; \
        pg8::StaticOrder S; S.init((M_), (N_), G, bx); pg8::EpiBf16P E{(pg8::bf16_t*)(Op), (ldc_)}; \
        pg8::gemm_phase<pg8::EpiBf16P, pg8::StaticOrder, true>(ldsb + RING_OFF, g, S, E); } while (0)
#define GEMM_RESB(RF32, Ap, lda_, Btp, K_, Rp) do { pg8::Gemm g{(const pg8::bf16_t*)(Ap), (const pg8::bf16_t*)(Btp), NTOK, DM, (K_), (lda_), (K_)}; \
        pg8::StaticOrder S; S.init(NTOK, DM, G, bx); pg8::EpiResB<RF32> E{(pg8::bf16_t*)WSB(WS_X), (const void*)(Rp)}; \
        pg8::gemm_phase<pg8::EpiResB<RF32>, pg8::StaticOrder, true>(ldsb + RING_OFF, g, S, E); } while (0)
#define GEMM_F32(Ap, lda_, Btp, ldb_, M_, N_, K_, Op, Rp, ldc_) do { pg8::Gemm g{(const pg8::bf16_t*)(Ap), (const pg8::bf16_t*)(Btp), (M_), (N_), (K_), (lda_), (ldb_)}; \
        pg8::StaticOrder S; S.init((M_), (N_), G, bx); pg8::EpiF32 E{(Op), (Rp), (ldc_)}; \
        pg8::gemm_phase<pg8::EpiF32, pg8::StaticOrder, true>(ldsb + RING_OFF, g, S, E); } while (0)

#define GEMM_CONVACT(Ap, Btp, cwp, cbp) do { pg8::Gemm g{(const pg8::bf16_t*)(Ap), (const pg8::bf16_t*)(Btp), NTOK, DFF2, DM, DM, DM}; \
        pg8::StaticOrder S; S.init(NTOK, DFF2, G, bx); pg8::EpiConvAct E{(pg8::bf16_t*)WSB(WS_ACT), WSF(WS_HALO), WSF(WS_RAWG), WSF(WS_RAWU), (cwp), (cbp)}; \
        pg8::gemm_phase<pg8::EpiConvAct, pg8::StaticOrder, true>(ldsb + RING_OFF, g, S, E); } while (0)

    if (IN(0)) { MKCTX(); KARG_DECL();
        for (int rep_ = 0; rep_ < REP_CONV; ++rep_) {
        convert_fast(C, INF(4), DM, 2048, WSB(WS_WKV), DM, 0);
        convert_fast(C, INF(6), DM, A_IN, WSB(WS_WAIN), DM, 0);
        convert_fast(C, INF(7), A_CAT, DM, WSB(WS_WAOUT), A_CAT, 0);
        convert_fast(C, INF(9), DM, B_IN, WSB(WS_WBIN), DM, 0);
        convert_job(C, INF(12), 128, MIXW, WSB(WS_WLW), 256, 0, 256, 0);
        convert_job(C, INF(14), 128, MIXW, WSB(WS_WLA), 256, 128, 256, 0);
        convert_job(C, INF(16), 96, MIXW, WSB(WS_WLV), 256, 0, 256, 0);
        convert_job(C, INF(17), 480, MIXW, WSB(WS_WLG), 512, 0, 512, 0);
        convert_fast(C, INF(25), DM, DFF2, WSB(WS_WUP), DM, 1);
        convert_fast(C, INF(28), DFF, DM, WSB(WS_WDOWN), DFF, 0);
        }
        rope_table(C, (const int*)INF(2), WSF(WS_ROPE));
        rmsnorm_rows<false>(C, INF(1), INF(3), WSB(WS_MEMN), NMEM);
        rmsnorm_rows<false>(C, INF(0), INF(5), WSB(WS_H), NTOK);
    }
    SEAM(0);
    if (IN(2)) { pg8::Gemm g{(const pg8::bf16_t*)WSB(WS_H), (const pg8::bf16_t*)WSB(WS_WAIN), NTOK, A_IN, DM, DM, DM};
        pg8::StaticOrder S; S.init(NTOK, A_IN, G, bx); pg8::EpiAin E{(pg8::bf16_t*)WSB(WS_P), (pg8::bf16_t*)WSB(WS_VFIRST), WSF(WS_ROPE), (pg8::bf16_t*)WSB(WS_Y)};
        pg8::gemm_phase<pg8::EpiAin, pg8::StaticOrder, true>(ldsb + RING_OFF, g, S, E); }
    SEAM(2);
    if (IN(3)) {
        if (bx < 16) GEMM_BF16(WSB(WS_MEMN), DM, WSB(WS_WKV), DM, NMEM, 2048, DM, WSB(WS_MEMKV), 2048);
        else { MKCTX(); KARG_DECL(); vt_build(C, WSB(WS_VFIRST), WSB(WS_VT), (bx - 16) * NWAVES + C.wave, (G - 16) * NWAVES);
            convert_fast(C, INF(28) + WDOWN_L, DFF, DM, WSB(WS_WDOWN) + WDOWN_L, DFF, 0, (bx - 16) * NWAVES + C.wave, (G - 16) * NWAVES); }
    }
    SEAM(3);
    if (IN(4)) for (int rep_ = 0; rep_ < REP_ATT; ++rep_) { MKCTX(); KARG_DECL(); attn_mfma(C, WSB(WS_P), WSB(WS_Y), WSB(WS_VT), WSB(WS_CAT)); xattn_lds(C, WSB(WS_P), PA_CQ, WSB(WS_MEMKV), WSB(WS_MEMKV), WSB(WS_CAT), A_CAT, A_OUTW, bx, G); }
    SEAM(4);
    if (IN(6)) { KARG_DECL(); GEMM_RESB(true, WSB(WS_CAT), A_CAT, WSB(WS_WAOUT), A_CAT, INF(0)); }
    SEAM(6);
    if (IN(7)) { MKCTX(); KARG_DECL(); rmsnorm_rows_b<false>(C, WSB(WS_X), INF(24), WSB(WS_H), NTOK); }
    SEAM(7);
    if (IN(8)) { KARG_DECL(); for (int rep_ = 0; rep_ < REP_UP; ++rep_) GEMM_CONVACT(WSB(WS_H), WSB(WS_WUP), INF(26), INF(27)); }
    SEAM(8);
    if (IN(9)) { MKCTX(); KARG_DECL(); convact_fixup(C, WSF(WS_HALO), WSF(WS_RAWG), WSF(WS_RAWU), INF(26), INF(27), WSB(WS_ACT)); }
    SEAM(9);
    if (IN(10)) GEMM_RESB(false, WSB(WS_ACT), DFF, WSB(WS_WDOWN), DFF, WSB(WS_X));
    SEAM(10);
    if (IN(11)) { MKCTX(); KARG_DECL(); rmsnorm_rows_b<false>(C, WSB(WS_X), INF(8), WSB(WS_H), NTOK); }
    SEAM(11);
    if (IN(12)) GEMM_BF16(WSB(WS_H), DM, WSB(WS_WBIN), DM, NTOK, B_IN_PAD, DM, WSB(WS_P), LDP);
    SEAM(12);
    if (IN(13)) for (int rl_ = 0; rl_ < REP_LORA; ++rl_) { MKCTX(); KARG_DECL(); prep_b1(C, WSB(WS_P), INF(10), WSB(WS_LA)); }
    SEAM(13);
    if (IN(14)) for (int rl_ = 0; rl_ < REP_LORA; ++rl_) { KARG_DECL();
#define GEMM_LORA(MODE, Ap, Btp, K_, Op, biasp) GEMM_LORA2(MODE, MIXW, Ap, Btp, K_, Op, biasp, (pg8::bf16_t*)nullptr, (const float*)nullptr)
#define GEMM_LORA2(MODE, N_, Ap, Btp, K_, Op, biasp, O2p, bias2p) do { int kv_ = (K_); asm volatile("" : "+s"(kv_)); pg8::Gemm g{(const pg8::bf16_t*)(Ap), (const pg8::bf16_t*)(Btp), NTOK, (N_), kv_, 1024, kv_}; \
        pg8::StaticOrder S; S.init(NTOK, (N_), G, bx); pg8::EpiLora<MODE> E{(pg8::bf16_t*)(Op), (biasp), (const pg8::bf16_t*)WSB(WS_P), INF(10), (const pg8::bf16_t*)WSB(WS_VFIRST), (pg8::bf16_t*)(O2p), (bias2p)}; \
        pg8::gemm_phase<pg8::EpiLora<MODE>, pg8::StaticOrder, true>(ldsb + RING_OFF, g, S, E); } while (0)
        GEMM_LORA2(4, 2 * MIXW, WSB(WS_LA), WSB(WS_WLW), 256, WSF(WS_SW), INF(11), WSF(WS_SA), INF(13));
        GEMM_LORA(2, WSB(WS_LA) + 256, WSB(WS_WLV), 256, WSF(WS_SV), INF(15));
        GEMM_LORA(3, WSB(WS_LA) + 512, WSB(WS_WLG), 512, WSF(WS_G), (const float*)nullptr);
    }
    SEAM(14);
    if (IN(15)) for (int rp_ = 0; rp_ < REP_SPRE; ++rp_) { MKCTX(); KARG_DECL(); scan_pre(C, WSB(WS_P), INF(10), INF(18), INF(19), INF(20), WSB(WS_SW), WSB(WS_SA), WSB(WS_SV), WSB(WS_G), ws + WS_CH); }
    SEAM(15);
    if (IN(17)) for (int rep_ = 0; rep_ < REP_SCAN; ++rep_) { MKCTX(); KARG_DECL();
        if (bx < BATCH * RH) for (int rs_ = 0; rs_ < REP_SONLY; ++rs_) scan_seq2(C, ws + WS_CH, INF(21), INF(22), WSB(WS_CAT));
        else { xattn_lds(C, WSB(WS_P), PB_CQ, WSB(WS_MEMKV), WSB(WS_MEMKV), WSB(WS_CAT), DM, MIXW, bx - BATCH * RH, G - BATCH * RH);
            __syncthreads();
            const int cgw = (bx - BATCH * RH) * NWAVES + C.wave, cng = (G - BATCH * RH) * NWAVES;
            convert_fast(C, INF(23), DM, DM, WSB(WS_WBOUT), DM, 0, cgw, cng);
            convert_fast(C, INF(25) + WUP_L, DM, DFF2, WSB(WS_WUP) + WUP_L, DM, 1, cgw, cng);
            }
    }
    SEAM(17);
    if (IN(18)) GEMM_RESB(false, WSB(WS_CAT), DM, WSB(WS_WBOUT), DM, WSB(WS_X));
    SEAM(18);
    if (IN(19)) { MKCTX(); KARG_DECL(); rmsnorm_rows_b<false>(C, WSB(WS_X), INF(24) + DM, WSB(WS_H), NTOK); }
    SEAM(19);
    if (IN(20)) { KARG_DECL(); for (int rep_ = 0; rep_ < REP_UP; ++rep_) GEMM_CONVACT(WSB(WS_H), WSB(WS_WUP) + WUP_L, INF(26) + 3 * DFF, INF(27) + DFF); }
    SEAM(20);
    if (IN(21)) { MKCTX(); KARG_DECL(); convact_fixup(C, WSF(WS_HALO), WSF(WS_RAWG), WSF(WS_RAWU), INF(26) + 3 * DFF, INF(27) + DFF, WSB(WS_ACT)); }
    SEAM(21);
    if (IN(22)) GEMM_RESB(false, WSB(WS_ACT), DFF, WSB(WS_WDOWN) + WDOWN_L, DFF, WSB(WS_X));
    SEAM(22);
    if (IN(23)) { MKCTX(); KARG_DECL(); rmsnorm_rows_b<true>(C, WSB(WS_X), INF(29), (void*)INF(30), NTOK); }
#undef IN
#undef SEAM
}

#ifndef MK_ONE_LAUNCH
#define MK_ONE_LAUNCH 0
#endif
extern "C" void kernel_launch(void* const* d_in, const int* in_sizes, int n_in, void* d_out, int out_size, void* d_ws, size_t ws_size, hipStream_t stream) {
    static int grid = 0;
    if (grid == 0) {
        if (n_in != 30 || out_size != NTOK * DM || ws_size < WS_END) { fprintf(stderr, "kernel_launch: unexpected shapes: n_in %d out %d ws %zu (need %zu)\n", n_in, out_size, ws_size, (size_t)WS_END); grid = -1; return; }
        int dev = 0, cus = 0, per_cu = 0;
        if (hipGetDevice(&dev) != hipSuccess || hipDeviceGetAttribute(&cus, hipDeviceAttributeMultiprocessorCount, dev) != hipSuccess) { grid = -1; return; }
        if (hipFuncSetAttribute((const void*)mk_fwd, hipFuncAttributeMaxDynamicSharedMemorySize, LDS_BYTES) != hipSuccess) { fprintf(stderr, "kernel_launch: hipFuncSetAttribute failed\n"); grid = -1; return; }
        if (hipOccupancyMaxActiveBlocksPerMultiprocessor(&per_cu, (const void*)mk_fwd, NTHREADS, LDS_BYTES) != hipSuccess || per_cu < 1) { fprintf(stderr, "kernel_launch: occupancy query says %d\n", per_cu); }
        (void)hipGetLastError();
        grid = cus;
    }
    if (grid < 0) return;
    (void)hipMemsetAsync((char*)d_ws + WS_CTL, 0, CTL_ZERO_BYTES, stream);
    Args a{};
    for (int i = 0; i < 30; ++i) a.in[i] = d_in[i];
    a.out = (float*)d_out; a.ws = (unsigned char*)d_ws;
#if MK_ONE_LAUNCH
    a.ph_lo = 0; a.ph_hi = N_PHASES;
    hipLaunchKernelGGL(mk_fwd, dim3(grid), dim3(NTHREADS), LDS_BYTES, stream, a);
#else
    for (int p = 0; p < N_PHASES; ++p) { a.ph_lo = p; a.ph_hi = p + 1; hipLaunchKernelGGL(mk_fwd, dim3(grid), dim3(NTHREADS), LDS_BYTES, stream, a); }
#endif
}
```

```cpp
#include <hip/hip_runtime.h>
#include <cstdio>
#include <cstdint>
#define MK_ONE_LAUNCH 1
namespace pg8 {
#define PG8_LAS __attribute__((address_space(3)))
typedef unsigned short bf16_t;
typedef short bf16x8 __attribute__((ext_vector_type(8)));
typedef float f32x4 __attribute__((ext_vector_type(4)));
typedef unsigned u32x4 __attribute__((ext_vector_type(4)));
constexpr int BM = 256, BK = 64, HALF = 128, HTB = HALF * BK * 2  , STAGE_BYTES = 8 * HTB, NXCD = 8, WGM = 8;

__host__ __device__ __forceinline__ int lds_byte(int r, int c) { const int st = (r >> 4) * 2 + (c >> 5), rr = r & 15, cc = c & 31, ob = rr * 64 + cc * 2; return st * 1024 + (ob ^ (((ob >> 9) & 1) << 5)); }
__host__ __device__ __forceinline__ void stage_rc(int b, int& R, int& C) { const int st = b / 1024, sb = b % 1024, swz = sb ^ (((sb >> 9) & 1) << 5); R = (st >> 1) * 16 + swz / 64; C = (st & 1) * 32 + (swz % 64) / 2; }
__host__ __device__ __forceinline__ int perm32(int rho) { const int n = rho >> 4, i = rho & 15; return 8 * (i >> 2) + 4 * n + (i & 3); }

struct Unit { int pm, pn; };
struct Gemm { const bf16_t* A; const bf16_t* Bt; int M, N, K, lda, ldb; };

struct StaticOrder {
    int nM, nN, nwg, G, c;
    __host__ __device__ void init(int M, int N, int G_, int c_) { nM = M / BM; nN = N / BM; nwg = nM * nN; G = G_; c = c_; }
    __host__ __device__ bool next(int i, Unit& u) const {
        const long L = (long)i * G + c; if (L >= nwg) return false;
        int wgid = (int)L; { const int q = nwg / NXCD, r = nwg % NXCD, xcd = wgid % NXCD, off = wgid / NXCD; wgid = (xcd < r ? xcd * (q + 1) : r * (q + 1) + (xcd - r) * q) + off; }
        const int nig = WGM * nN, gid = wgid / nig, fm = gid * WGM, gsz = (nM - fm) < WGM ? (nM - fm) : WGM;
        u.pm = fm + ((wgid % nig) % gsz); u.pn = (wgid % nig) / gsz; return true;
    }
    __device__ __forceinline__ void a_ready(const Unit&) const {}
    __device__ __forceinline__ void done(const Unit&) const {}
};

__device__ __forceinline__ unsigned cvt_pk_bf16(float lo, float hi) { unsigned r; asm volatile("v_cvt_pk_bf16_f32 %0, %1, %2" : "=v"(r) : "v"(lo), "v"(hi)); return r; }

struct EpiBf16P {
    static constexpr bool PERM = true, AFTER_DRAIN = false;
    bf16_t* O; int ldc;
    __device__ __forceinline__ void operator()(const f32x4 (&acc)[2][2][4][2], const Unit& u, int, int, int, int) const {
        int t_ = threadIdx.x; asm volatile("" : "+v"(t_)); const int wid_ = __builtin_amdgcn_readfirstlane(t_ >> 6), wr = wid_ >> 2, wc = wid_ & 3, fr = t_ & 15, fq = (t_ >> 4) & 3;
        const int row0 = u.pm * BM + wr * 64 + fr; const int col0 = u.pn * BM + wc * 32 + 8 * fq;
#pragma unroll
        for (int ai = 0; ai < 2; ++ai)
#pragma unroll
            for (int m = 0; m < 4; ++m) { bf16_t* rowp = O + (size_t)(row0 + ai * HALF + m * 16) * ldc + col0;
#pragma unroll
                for (int bj = 0; bj < 2; ++bj) { const f32x4 v0 = acc[ai][bj][m][0], v1 = acc[ai][bj][m][1];
                    u32x4 w; w.x = cvt_pk_bf16(v0[0], v0[1]); w.y = cvt_pk_bf16(v0[2], v0[3]); w.z = cvt_pk_bf16(v1[0], v1[1]); w.w = cvt_pk_bf16(v1[2], v1[3]);
                    *(u32x4*)(rowp + bj * HALF) = w; } }
    }
};
struct EpiF32 {
    static constexpr bool PERM = false, AFTER_DRAIN = false;
    float* O; const float* R; int ldc;
    __device__ __forceinline__ void operator()(const f32x4 (&acc)[2][2][4][2], const Unit& u, int, int, int, int) const {
        int t_ = threadIdx.x; asm volatile("" : "+v"(t_)); const int wid_ = __builtin_amdgcn_readfirstlane(t_ >> 6), wr = wid_ >> 2, wc = wid_ & 3, fr = t_ & 15, fq = (t_ >> 4) & 3;
        const int row0 = u.pm * BM + wr * 64 + fr; const int col0 = u.pn * BM + wc * 32 + 4 * fq;
#pragma unroll
        for (int ai = 0; ai < 2; ++ai)
#pragma unroll
            for (int m = 0; m < 4; ++m) { const size_t off = (size_t)(row0 + ai * HALF + m * 16) * ldc + col0;
#pragma unroll
                for (int bj = 0; bj < 2; ++bj)
#pragma unroll
                    for (int n = 0; n < 2; ++n) { f32x4 v = acc[ai][bj][m][n]; const size_t o = off + bj * HALF + n * 16;
                        if (R) v = v + *(const f32x4*)(R + o);
                        *(f32x4*)(O + o) = v; } }
    }
};

template <class Epi, class Sched, bool ALIGN_EPI = false>
__device__ __forceinline__ void gemm_phase(PG8_LAS unsigned char* lds, const Gemm g, const Sched& S, const Epi& E) {
    int tid_ = threadIdx.x; asm volatile("" : "+v"(tid_));
    const int tid = tid_, wid = __builtin_amdgcn_readfirstlane(tid >> 6), lane = tid & 63, wr = wid >> 2, wc = wid & 3, fr = lane & 15, fq = lane >> 4;
    const int K = g.K, nt = K / BK;
    unsigned voffA[2], voffB[2];
#pragma unroll
    for (int i = 0; i < 2; ++i) { int R, C; stage_rc(tid * 16 + i * 8192, R, C); const int Rb = Epi::PERM ? ((R & ~31) + perm32(R & 31)) : R;
        voffA[i] = (unsigned)(R * g.lda + C) * 2u; voffB[i] = (unsigned)(Rb * g.ldb + C) * 2u; }
    const size_t kstep = (size_t)(BK * 2);
    const size_t hstepA = (size_t)HALF * g.lda * 2, hstepB = (size_t)HALF * g.ldb * 2;
    const size_t tstepA = 2 * hstepA, tstepB = 2 * hstepB;
    const unsigned ldsw = (unsigned)wid * 1024u;
    const int aoff = lds_byte(wr * 64 + fr, fq * 8), boff = lds_byte(wc * 32 + fr, fq * 8);
#define PG8_SA(b, h) (((b) * 2 + (h)) * HTB)
#define PG8_SB(b, h) ((4 + (b) * 2 + (h)) * HTB)
#define PG8_STAGE(bufoff, gbase, voff) do { _Pragma("unroll") for (int _i = 0; _i < 2; ++_i) \
        __builtin_amdgcn_global_load_lds((const unsigned*)((const char*)(gbase) + (voff)[_i]), (PG8_LAS unsigned*)(lds + (bufoff) + ldsw + _i * 8192), 16, 0, 0); } while (0)
#define PG8_LDA(dst, b, h) do { _Pragma("unroll") for (int m = 0; m < 4; ++m) _Pragma("unroll") for (int k = 0; k < 2; ++k) dst[m][k] = *(const PG8_LAS bf16x8*)(lds + PG8_SA(b, h) + aoff + m * 2048 + k * 1024); } while (0)
#define PG8_LDB(dst, b, h) do { _Pragma("unroll") for (int n = 0; n < 2; ++n) _Pragma("unroll") for (int k = 0; k < 2; ++k) dst[n][k] = *(const PG8_LAS bf16x8*)(lds + PG8_SB(b, h) + boff + n * 2048 + k * 1024); } while (0)
#define PG8_MMA(ai, bj, At, Bt) do { __builtin_amdgcn_s_setprio(1); _Pragma("unroll") for (int m = 0; m < 4; ++m) _Pragma("unroll") for (int n = 0; n < 2; ++n) _Pragma("unroll") for (int k = 0; k < 2; ++k) \
        acc[ai][bj][m][n] = __builtin_amdgcn_mfma_f32_16x16x32_bf16(Bt[n][k], At[m][k], acc[ai][bj][m][n], 0, 0, 0); __builtin_amdgcn_s_setprio(0); } while (0)
#define PG8_WAIT_V(n) asm volatile("s_waitcnt vmcnt(" #n ")" ::: "memory")
#define PG8_WAIT_L(n) asm volatile("s_waitcnt lgkmcnt(" #n ")" ::: "memory")
#define PG8_BAR __builtin_amdgcn_s_barrier()
#define PG8_SCHED __builtin_amdgcn_sched_barrier(0)
    Unit cur, nxt; int ui = 0;
    if (!S.next(0, cur)) return;
    f32x4 acc[2][2][4][2];
#pragma unroll
    for (int a = 0; a < 2; ++a)
#pragma unroll
        for (int b = 0; b < 2; ++b)
#pragma unroll
            for (int m = 0; m < 4; ++m)
#pragma unroll
                for (int n = 0; n < 2; ++n) acc[a][b][m][n] = (f32x4){0.f, 0.f, 0.f, 0.f};
    bf16x8 At[4][2], B0[2][2], B1[2][2];
    const char* cA = (const char*)g.A + (size_t)cur.pm * tstepA; const char* cB = (const char*)g.Bt + (size_t)cur.pn * tstepB;
    S.a_ready(cur);
    PG8_STAGE(PG8_SB(0, 0), cB, voffB); PG8_STAGE(PG8_SB(0, 1), cB + hstepB, voffB); PG8_STAGE(PG8_SA(0, 0), cA, voffA); PG8_STAGE(PG8_SA(0, 1), cA + hstepA, voffA);
    if (wr == 1) PG8_BAR;
    PG8_WAIT_V(2); PG8_BAR;
    PG8_STAGE(PG8_SB(1, 0), cB + kstep, voffB); PG8_STAGE(PG8_SA(1, 0), cA + kstep, voffA); PG8_STAGE(PG8_SB(1, 1), cB + hstepB + kstep, voffB);
    PG8_WAIT_V(6); PG8_BAR;
    for (;;) {
        const bool has_next = S.next(ui + 1, nxt);
        const char* nA = has_next ? (const char*)g.A + (size_t)nxt.pm * tstepA : cA; const char* nB = has_next ? (const char*)g.Bt + (size_t)nxt.pn * tstepB : cB;
        for (int t = 0; t < nt; t += 2) {
            const bool last = (t == nt - 2);
            const char* a1 = cA + (size_t)(t + 1) * kstep;
            const char* a2 = last ? nA : cA + (size_t)(t + 2) * kstep; const char* b2 = last ? nB : cB + (size_t)(t + 2) * kstep;
            const char* a3 = a2 + kstep; const char* b3 = b2 + kstep;
            if (last && has_next) S.a_ready(nxt);
            PG8_LDB(B0, 0, 0); PG8_LDB(B1, 0, 1); PG8_SCHED; PG8_LDA(At, 0, 0); PG8_STAGE(PG8_SA(1, 1), a1 + hstepA, voffA);
            PG8_WAIT_V(8); PG8_WAIT_L(0); PG8_BAR; PG8_MMA(0, 0, At, B0); PG8_MMA(0, 1, At, B1); PG8_BAR; PG8_SCHED;
            PG8_LDA(At, 0, 1); PG8_STAGE(PG8_SB(0, 0), b2, voffB); PG8_STAGE(PG8_SB(0, 1), b2 + hstepB, voffB); PG8_STAGE(PG8_SA(0, 0), a2, voffA);
            PG8_WAIT_V(8); PG8_WAIT_L(0); PG8_BAR; PG8_MMA(1, 0, At, B0); PG8_MMA(1, 1, At, B1); PG8_BAR; PG8_SCHED;
            PG8_LDB(B0, 1, 0); PG8_LDB(B1, 1, 1); PG8_SCHED; PG8_LDA(At, 1, 0); PG8_STAGE(PG8_SA(0, 1), a2 + hstepA, voffA);
            PG8_WAIT_V(8); PG8_WAIT_L(0); PG8_BAR; PG8_MMA(0, 0, At, B0); PG8_MMA(0, 1, At, B1); PG8_BAR; PG8_SCHED;
            PG8_LDA(At, 1, 1); PG8_STAGE(PG8_SB(1, 0), b3, voffB); PG8_STAGE(PG8_SB(1, 1), b3 + hstepB, voffB); PG8_STAGE(PG8_SA(1, 0), a3, voffA);
            PG8_WAIT_V(8); PG8_WAIT_L(0); PG8_BAR; PG8_MMA(1, 0, At, B0); PG8_MMA(1, 1, At, B1); PG8_BAR; PG8_SCHED;
        }
        if constexpr (ALIGN_EPI) { if (wr == 0) PG8_BAR; }
        E(acc, cur, wr, wc, fr, fq); S.done(cur);
        if (!has_next) break;
#pragma unroll
        for (int a = 0; a < 2; ++a)
#pragma unroll
            for (int b = 0; b < 2; ++b)
#pragma unroll
                for (int m = 0; m < 4; ++m)
#pragma unroll
                    for (int n = 0; n < 2; ++n) acc[a][b][m][n] = (f32x4){0.f, 0.f, 0.f, 0.f};
        cur = nxt; cA = nA; cB = nB; ++ui;
        if constexpr (ALIGN_EPI) { if (wr == 1) PG8_BAR; }
    }
    PG8_WAIT_V(0);
    if constexpr (!ALIGN_EPI) { if (wr == 0) PG8_BAR; }
    PG8_BAR;
#undef PG8_SA
#undef PG8_SB
#undef PG8_STAGE
#undef PG8_LDA
#undef PG8_LDB
#undef PG8_MMA
#undef PG8_WAIT_V
#undef PG8_WAIT_L
#undef PG8_BAR
#undef PG8_SCHED
}
}
constexpr int NWAVES = 8, NTHREADS = 512;
constexpr int BATCH = 2, SEQ = 4096, DM = 4096, NTOK = BATCH * SEQ;
constexpr int MEM_LEN = 256, NMEM = BATCH * MEM_LEN;
constexpr int XW = 1024, XH = 4, XHD = 256, MIXW = 3072;
constexpr int A_IN = 10240, A_OUTW = 1024, A_CAT = 2048;
constexpr int B_SHIFT = 10048, B_IN = 11072, B_IN_PAD = 11264;
constexpr int LDP = 11264;
constexpr int DFF = 14336, DFF2 = 28672;
constexpr int RH = 48, RHD = 64;
constexpr float NORM_EPS = 1e-6f, GN_EPS = 64e-5f;
constexpr int PB_R = 0, PB_K = 3072, PB_V = 6144, PB_WD = 9216, PB_AD = 9344, PB_VD = 9472, PB_GD = 9568, PB_CQ = 10048;
constexpr int PA_Q = 0, PA_K = 3072, PA_V = 6144, PA_CQ = 9216;

constexpr size_t MiB = 1u << 20;
constexpr size_t WS_CTL = 0, CTL_ZERO_BYTES = 65536;
constexpr size_t WS_ROPE = 1 * MiB;
constexpr size_t WS_WKV = 2 * MiB;
constexpr size_t WS_WAIN = 18 * MiB;
constexpr size_t WS_WAOUT = 98 * MiB;
constexpr size_t WS_WBIN = 114 * MiB;
constexpr size_t WS_WLW = 202 * MiB;
constexpr size_t WS_WLA = WS_WLW + 3 * MiB / 2;
constexpr size_t WS_WLV = WS_WLA + 3 * MiB / 2;
constexpr size_t WS_WLG = WS_WLV + 3 * MiB / 2;
constexpr size_t WS_WBOUT = 210 * MiB;
constexpr size_t WS_WUP = 242 * MiB;
constexpr size_t WS_WDOWN = 690 * MiB;
constexpr size_t WS_X = 914 * MiB;
constexpr size_t WS_H = 1042 * MiB;
constexpr size_t WS_MEMN = 1106 * MiB;
constexpr size_t WS_MEMKV = 1110 * MiB;
constexpr size_t WS_P = 1112 * MiB;
constexpr size_t WS_VFIRST = 1288 * MiB;
constexpr size_t WS_CAT = 1336 * MiB;
constexpr size_t WS_ACT = 1400 * MiB;
constexpr size_t WS_GU = 1624 * MiB;
constexpr size_t WS_HALO = 1624 * MiB, WS_RAWG = 1640 * MiB, WS_RAWU = 1656 * MiB;
constexpr size_t WS_CH = 1680 * MiB;
constexpr size_t WS_SR = 2072 * MiB;
constexpr size_t WS_SW = WS_SR + 96 * MiB, WS_SK = WS_SR + 192 * MiB, WS_SV = WS_SR + 288 * MiB, WS_SA = WS_SR + 384 * MiB, WS_SB = WS_SR + 480 * MiB;
constexpr size_t WS_G = 2648 * MiB;
constexpr size_t WS_Y = 2744 * MiB;
constexpr size_t WS_VT = 2840 * MiB;
constexpr size_t WS_OG = 2840 * MiB;
constexpr size_t WS_LSE = 2936 * MiB;
constexpr size_t WS_LA = 2937 * MiB;
constexpr size_t WS_MEMVT = 2953 * MiB;
constexpr size_t WS_END = 2954 * MiB;
constexpr int CW_TMO = 0, CW_CODE = 1, CW_BAR = 4096;

constexpr int RING_OFF = 0, RING_BYTES = 131072;
constexpr int LDSCTL_OFF = RING_BYTES, MISC_OFF = LDSCTL_OFF + 320;
constexpr int LDS_BYTES = 147456;

#define GAS __attribute__((address_space(1)))
#define LAS __attribute__((address_space(3)))
typedef unsigned short bf16;
typedef unsigned v4u __attribute__((ext_vector_type(4)));
typedef unsigned v2u __attribute__((ext_vector_type(2)));
typedef float f32x4 __attribute__((ext_vector_type(4)));
typedef float f32x2 __attribute__((ext_vector_type(2)));
typedef GAS unsigned gu32;
#define RLX_AGENT __ATOMIC_RELAXED, __HIP_MEMORY_SCOPE_AGENT
#define LDS_WAIT() asm volatile("s_waitcnt lgkmcnt(0)" ::: "memory")
#define VM_WAIT() asm volatile("s_waitcnt vmcnt(0)" ::: "memory")
__device__ __forceinline__ unsigned f2bf(float f) { unsigned u = __builtin_bit_cast(unsigned, f); return (u + 0x7fffu + ((u >> 16) & 1u)) >> 16; }
__device__ __forceinline__ unsigned pk2(float lo, float hi) { return f2bf(lo) | (f2bf(hi) << 16); }
__device__ __forceinline__ float bf2f(unsigned short h) { return __builtin_bit_cast(float, (unsigned)h << 16); }
__device__ __forceinline__ float bflo(unsigned w) { return __builtin_bit_cast(float, w << 16); }
__device__ __forceinline__ float bfhi(unsigned w) { return __builtin_bit_cast(float, w & 0xffff0000u); }
__device__ __forceinline__ float sigmoidf_(float x) { return 1.f / (1.f + __expf(-x)); }

#define XB_TMO      128
#define XB_XCNT(j)  (256  + 64 * (j))
#define XB_XSUB(j)  (1280 + 64 * (j))
#define XB_XGEN(j)  (2304 + 64 * (j))
#define XB_TOP      3328
#define XB_TOPGEN   3392
#define XCD_BAR_WORDS 3456
#define XB_SPIN_CAP (1u << 22)

__device__ __forceinline__ unsigned xb_ld(unsigned* p)              { return __hip_atomic_load(p, __ATOMIC_RELAXED, __HIP_MEMORY_SCOPE_AGENT); }
__device__ __forceinline__ unsigned xb_add(unsigned* p, unsigned v) { return __hip_atomic_fetch_add(p, v, __ATOMIC_RELAXED, __HIP_MEMORY_SCOPE_AGENT); }
__device__ __forceinline__ unsigned xb_xcc_id() { return (unsigned)__builtin_amdgcn_s_getreg((3 << 11) | 20) & 0xFu; }
#define XB_SPIN(cond, bar) do { unsigned _sp = 0; while (cond) { __builtin_amdgcn_s_sleep(1); \
    if ((++_sp & 255u) == 0u) { if (xb_ld(&(bar)[XB_TMO])) break; if (_sp > XB_SPIN_CAP) { atomicAdd(&(bar)[XB_TMO], 1u); break; } } } } while (0)

struct XcdBarrier {
    unsigned* bar; unsigned x;
    volatile LAS unsigned* st;
};
__device__ __forceinline__ XcdBarrier xcd_barrier_post(unsigned* bar, volatile LAS unsigned* st) {
    XcdBarrier b; b.bar = bar; b.x = xb_xcc_id(); b.st = st;
    if (threadIdx.x == 0) (void)xb_add(&bar[XB_XCNT(b.x)], 1u);
    return b;
}
__device__ __forceinline__ void xcd_barrier_complete(unsigned* bar, unsigned x, unsigned& nloc, unsigned& nx) {
    const unsigned G = gridDim.x * gridDim.y * gridDim.z;
    unsigned sum, cnt, mine, sp = 0u;
    for (;;) {
        sum = 0u; cnt = 0u; mine = 0u;
#pragma unroll
        for (unsigned j = 0; j < 16; ++j) { const unsigned c = xb_ld(&bar[XB_XCNT(j)]); sum += c; cnt += (c > 0u) ? 1u : 0u; mine = (j == x) ? c : mine; }
        if (sum == G) break;
        __builtin_amdgcn_s_sleep(1);
        if ((++sp & 255u) == 0u) { if (xb_ld(&bar[XB_TMO])) break; if (sp > XB_SPIN_CAP) { atomicAdd(&bar[XB_TMO], 1u); break; } }
    }
    nloc = mine > 0u ? mine : 1u; nx = cnt > 0u ? cnt : 1u;
}
__device__ __forceinline__ void xcd_barrier(const XcdBarrier& b) {
    asm volatile("s_waitcnt vmcnt(0)" ::: "memory");
    __syncthreads();
    if (threadIdx.x == 0) {
        unsigned* bar = b.bar;
        __builtin_amdgcn_s_waitcnt(0);
        unsigned nloc = b.st[0], nx = b.st[1];
        if (nloc == 0u) { xcd_barrier_complete(bar, b.x, nloc, nx); b.st[0] = nloc; b.st[1] = nx; }
        const unsigned old = xb_add(&bar[XB_XSUB(b.x)], 1u);
        const unsigned gen = old / nloc;
        if (old + 1u == (gen + 1u) * nloc) {
            __builtin_amdgcn_fence(__ATOMIC_RELEASE, "agent");
            asm volatile("s_waitcnt vmcnt(0)" ::: "memory");
            const unsigned og = xb_add(&bar[XB_TOP], 1u);
            const unsigned tg = og / nx;
            if (og + 1u == (tg + 1u) * nx) xb_add(&bar[XB_TOPGEN], 1u);
            else XB_SPIN(xb_ld(&bar[XB_TOPGEN]) == tg, bar);
            __builtin_amdgcn_fence(__ATOMIC_ACQUIRE, "agent");
            xb_add(&bar[XB_XGEN(b.x)], 1u);
            asm volatile("s_waitcnt vmcnt(0)" ::: "memory");
        } else {
            XB_SPIN(xb_ld(&bar[XB_XGEN(b.x)]) == gen, bar);
            __builtin_amdgcn_fence(__ATOMIC_ACQUIRE, "agent");
            asm volatile("s_waitcnt vmcnt(0)" ::: "memory");
        }
    }
    __syncthreads();
}

template <int CTRL> __device__ __forceinline__ float dppf(float x) { return __builtin_bit_cast(float, __builtin_amdgcn_update_dpp(0, __builtin_bit_cast(int, x), CTRL, 0xf, 0xf, true)); }
__device__ __forceinline__ float row16_sum(float x) { x += dppf<0xB1>(x); x += dppf<0x4E>(x); x += dppf<0x141>(x); x += dppf<0x140>(x); return x; }

__device__ __forceinline__ float wave_sum_dpp(float x) {
    x = row16_sum(x);
    x += __builtin_bit_cast(float, __builtin_amdgcn_update_dpp(0, __builtin_bit_cast(int, x), 0x142, 0xa, 0xf, false));
    x += __builtin_bit_cast(float, __builtin_amdgcn_update_dpp(0, __builtin_bit_cast(int, x), 0x143, 0xc, 0xf, false));
    return __builtin_bit_cast(float, __builtin_amdgcn_readlane(__builtin_bit_cast(int, x), 63));
}
__device__ __forceinline__ float wave_sum(float v) { return wave_sum_dpp(v); }
struct Ctx { int tid, lane, wave, gw, NGW, gtid, GT; LAS unsigned char* lds; };

__device__ __forceinline__ void convert_job(const Ctx& C, const float* W, int K, int N, bf16* WT, int ldk, int koff, int Kpad, int mode) {
    LAS float* scr = (LAS float*)(C.lds + RING_OFF + C.wave * 16384);
    const int nblk = N / 32, nitems = (Kpad / 64) * nblk, lane = C.lane;
    for (int item = C.gw; item < nitems; item += C.NGW) {
        const int kb = item / nblk, nb = item % nblk, k0 = 64 * kb, n0 = 32 * nb;
#pragma unroll 8
        for (int i = 0; i < 32; ++i) { const int kk = 2 * i + (lane >> 5); const int ks = k0 + kk - koff;
            float v = 0.f; if (ks >= 0 && ks < K) v = W[(size_t)ks * N + n0 + (lane & 31)];
            scr[kk * 33 + (lane & 31)] = v; }
        LDS_WAIT(); asm volatile("" ::: "memory");
        const int c = lane & 7;
        int d0 = n0;
        if (mode == 1) { d0 = (n0 < DFF) ? (256 * (n0 / 128) + (n0 % 128)) : (256 * ((n0 - DFF) / 128) + 128 + ((n0 - DFF) % 128)); }
#pragma unroll
        for (int j = 0; j < 4; ++j) { const int n = (lane >> 3) + 8 * j; const LAS float* s = scr + (8 * c) * 33 + n;
            v4u o; o.x = pk2(s[0 * 33], s[1 * 33]); o.y = pk2(s[2 * 33], s[3 * 33]); o.z = pk2(s[4 * 33], s[5 * 33]); o.w = pk2(s[6 * 33], s[7 * 33]);
            *(v4u*)(WT + (size_t)(d0 + n) * ldk + k0 + 8 * c) = o; }
        LDS_WAIT(); asm volatile("" ::: "memory");
    }
}

template <bool OUT_F32>
__device__ __forceinline__ void rmsnorm_rows_b(const Ctx& C, const bf16* X, const float* g, void* out, int nrows) {
    for (int row = C.gw; row < nrows; row += C.NGW) {
        const v4u* xr = (const v4u*)(X + (size_t)row * DM) + C.lane;
        float v[8][8]; float s = 0.f;
#pragma unroll
        for (int j = 0; j < 8; ++j) { const v4u w = xr[64 * j];
#pragma unroll
            for (int e = 0; e < 4; ++e) { v[j][2 * e] = bflo(w[e]); v[j][2 * e + 1] = bfhi(w[e]); s += v[j][2 * e] * v[j][2 * e] + v[j][2 * e + 1] * v[j][2 * e + 1]; } }
        const float rstd = 1.f / sqrtf(wave_sum(s) * (1.f / DM) + NORM_EPS);
#pragma unroll
        for (int j = 0; j < 8; ++j) { const int c0 = 8 * (C.lane + 64 * j); const f32x4 g0 = *(const f32x4*)(g + c0), g1 = *(const f32x4*)(g + c0 + 4);
            float y[8];
#pragma unroll
            for (int e = 0; e < 4; ++e) { y[e] = v[j][e] * rstd * g0[e]; y[4 + e] = v[j][4 + e] * rstd * g1[e]; }
            if (OUT_F32) { float* op = (float*)out + (size_t)row * DM + c0; *(f32x4*)op = (f32x4){y[0], y[1], y[2], y[3]}; *(f32x4*)(op + 4) = (f32x4){y[4], y[5], y[6], y[7]}; }
            else { v4u w; w.x = pk2(y[0], y[1]); w.y = pk2(y[2], y[3]); w.z = pk2(y[4], y[5]); w.w = pk2(y[6], y[7]); *(v4u*)((bf16*)out + (size_t)row * DM + c0) = w; } }
    }
}
template <bool OUT_F32>
__device__ __forceinline__ void rmsnorm_rows(const Ctx& C, const float* X, const float* g, void* out, int nrows) {
    for (int row = C.gw; row < nrows; row += C.NGW) {
        const f32x4* xr = (const f32x4*)(X + (size_t)row * DM) + C.lane;
        f32x4 v[16]; float s = 0.f;
#pragma unroll
        for (int j = 0; j < 16; ++j) { v[j] = xr[64 * j]; s += (v[j].x * v[j].x + v[j].y * v[j].y) + (v[j].z * v[j].z + v[j].w * v[j].w); }
        const float rstd = 1.f / sqrtf(wave_sum(s) * (1.f / DM) + NORM_EPS);
        const f32x4* gr = (const f32x4*)g + C.lane;
#pragma unroll
        for (int j = 0; j < 16; ++j) { const f32x4 gg = gr[64 * j]; const f32x4 y = v[j] * rstd * gg;
            if (OUT_F32) ((f32x4*)((float*)out + (size_t)row * DM) + C.lane)[64 * j] = y;
            else { v2u w; w.x = pk2(y.x, y.y); w.y = pk2(y.z, y.w); ((v2u*)((bf16*)out + (size_t)row * DM) + C.lane)[64 * j] = w; } }
    }
}

__device__ __forceinline__ void rope_table(const Ctx& C, const int* pos, float* T) {
    for (int idx = C.gtid; idx < NTOK * 16; idx += C.GT) { const int row = idx >> 4, i = idx & 15;
        const float inv = powf(500000.0f, -(float)i / 16.0f); const float ang = (float)pos[row] * inv;
        T[2 * idx] = cosf(ang); T[2 * idx + 1] = sinf(ang); }
}


__device__ __forceinline__ float shiftv(const bf16* P, int row, int t, int c, const float* mu) {
    const float cur = bf2f(P[(size_t)row * LDP + c]); const float prev = (t > 0) ? bf2f(P[(size_t)(row - 1) * LDP + c]) : 0.f;
    return cur + (prev - cur) * mu[c];
}
__device__ __forceinline__ void prep_b1(const Ctx& C, const bf16* P, const float* mu, bf16* LA) {
    for (int idx = C.gtid; idx < NTOK * 128; idx += C.GT) { const int row = idx >> 7, c = (idx & 127) * 8, t = row & (SEQ - 1);
        int src = -1, mode = 0;
        if (c < 128) { src = PB_WD + c; mode = 1; } else if (c < 256) { src = PB_AD + (c - 128); mode = 2; } else if (c < 352) { src = PB_VD + (c - 256); mode = 2; }
        else if (c >= 512 && c < 992) { src = PB_GD + (c - 512); mode = 3; }
        v4u o = (v4u){0u, 0u, 0u, 0u};
        if (src >= 0) { const v4u cw = *(const v4u*)(P + (size_t)row * LDP + src); v4u pw = (v4u){0u, 0u, 0u, 0u}; if (t > 0) pw = *(const v4u*)(P + (size_t)(row - 1) * LDP + src);
            const f32x4 m0 = *(const f32x4*)(mu + src), m1 = *(const f32x4*)(mu + src + 4);
            float r[8];
#pragma unroll
            for (int e = 0; e < 8; ++e) { const float cur = (e & 1) ? bfhi(cw[e >> 1]) : bflo(cw[e >> 1]), prv = (e & 1) ? bfhi(pw[e >> 1]) : bflo(pw[e >> 1]), mm = (e < 4) ? m0[e & 3] : m1[e & 3];
                const float x = cur + (prv - cur) * mm; r[e] = (mode == 1) ? tanhf(x) : ((mode == 3) ? sigmoidf_(x) : x); }
            o.x = pk2(r[0], r[1]); o.y = pk2(r[2], r[3]); o.z = pk2(r[4], r[5]); o.w = pk2(r[6], r[7]); }
        *(v4u*)(LA + (size_t)row * 1024 + c) = o; }
}

typedef short bf16x8v __attribute__((ext_vector_type(8)));
typedef short bf16x4v __attribute__((ext_vector_type(4)));


__device__ __forceinline__ float SFMA(float a, float b, float c) { float d; asm("v_fma_f32 %0, %1, %2, %3" : "=v"(d) : "v"(a), "v"(b), "v"(c)); return d; }
__device__ __forceinline__ float SMUL(float a, float b) { float d; asm("v_mul_f32 %0, %1, %2" : "=v"(d) : "v"(a), "v"(b)); return d; }
constexpr int SC_T = 32, SC_N = SC_T * 64, SC_BUF = 6 * SC_N;

namespace pg8 {
template <int MODE> struct EpiLora {
    static constexpr bool PERM = true, AFTER_DRAIN = false;
    bf16_t* O; const float* bias; const bf16_t* P; const float* mu; const bf16_t* VF; bf16_t* O2; const float* bias2;
    __device__ __forceinline__ void operator()(const f32x4 (&acc)[2][2][4][2], const Unit& u, int, int, int, int) const {
        int t_ = threadIdx.x; asm volatile("" : "+v"(t_)); const int wid_ = __builtin_amdgcn_readfirstlane(t_ >> 6), wr = wid_ >> 2, wc = wid_ & 3, fr = t_ & 15, fq = (t_ >> 4) & 3;
        if constexpr (MODE == 2) {
            const int row0 = u.pm * BM + wr * 64 + fr; const int colt = u.pn * BM + wc * 32 + 8 * fq;
#pragma unroll
            for (int bj = 0; bj < 2; ++bj) { const int c = colt + bj * HALF;
                const f32x4 b0 = *(const f32x4*)(bias + c), b1 = *(const f32x4*)(bias + c + 4), m0 = *(const f32x4*)(mu + PB_V + c), m1 = *(const f32x4*)(mu + PB_V + c + 4);
#pragma unroll
                for (int ai = 0; ai < 2; ++ai)
#pragma unroll
                    for (int m = 0; m < 4; ++m) { const int row = row0 + ai * HALF + m * 16; const int t = row & (SEQ - 1);
                        const u32x4 cw = *(const u32x4*)(P + (size_t)row * LDP + PB_V + c); u32x4 pw = (u32x4){0u, 0u, 0u, 0u}; if (t > 0) pw = *(const u32x4*)(P + (size_t)(row - 1) * LDP + PB_V + c);
                        const u32x4 fw = *(const u32x4*)(VF + (size_t)row * MIXW + c);
                        f32x4 v0 = acc[ai][bj][m][0], v1 = acc[ai][bj][m][1];
#pragma unroll
                        for (int e = 0; e < 4; ++e) {
                            { const unsigned cwe = cw[e >> 1], pwe = pw[e >> 1], fwe = fw[e >> 1]; const float cur = (e & 1) ? bfhi(cwe) : bflo(cwe), prv = (e & 1) ? bfhi(pwe) : bflo(pwe), vf = (e & 1) ? bfhi(fwe) : bflo(fwe);
                              const float gt = __builtin_amdgcn_rcpf(1.f + __expf(-(b0[e] + v0[e]))); const float vs = cur + (prv - cur) * m0[e]; v0[e] = vs + (vf - vs) * gt; }
                            { const unsigned cwe = cw[2 + (e >> 1)], pwe = pw[2 + (e >> 1)], fwe = fw[2 + (e >> 1)]; const float cur = (e & 1) ? bfhi(cwe) : bflo(cwe), prv = (e & 1) ? bfhi(pwe) : bflo(pwe), vf = (e & 1) ? bfhi(fwe) : bflo(fwe);
                              const float gt = __builtin_amdgcn_rcpf(1.f + __expf(-(b1[e] + v1[e]))); const float vs = cur + (prv - cur) * m1[e]; v1[e] = vs + (vf - vs) * gt; } }
                        u32x4 w_; w_.x = cvt_pk_bf16(v0[0], v0[1]); w_.y = cvt_pk_bf16(v0[2], v0[3]); w_.z = cvt_pk_bf16(v1[0], v1[1]); w_.w = cvt_pk_bf16(v1[2], v1[3]);
                        *(u32x4*)(O + (size_t)row * MIXW + c) = w_; }
                asm volatile("" ::: "memory"); }
        } else {
            const int row0 = u.pm * BM + wr * 64 + fr; const int colt = u.pn * BM + wc * 32 + 8 * fq;
            const bool isw = (MODE == 4) ? (u.pn < 12) : true;
            const float sc_ = (MODE == 0 || (MODE == 4 && isw)) ? -0.6065306597126334f : 1.f;
            const float* bp = (MODE == 4 && !isw) ? bias2 : bias; bf16_t* Op = (MODE == 4 && !isw) ? O2 : O;
#pragma unroll
            for (int bj = 0; bj < 2; ++bj) { const int c = ((MODE == 4 && !isw) ? colt - MIXW : colt) + bj * HALF;
                f32x4 b0 = (f32x4){0.f, 0.f, 0.f, 0.f}, b1 = b0;
                if (MODE != 3) { b0 = *(const f32x4*)(bp + c); b1 = *(const f32x4*)(bp + c + 4); }
#pragma unroll
                for (int ai = 0; ai < 2; ++ai)
#pragma unroll
                    for (int m = 0; m < 4; ++m) { const int row = row0 + ai * HALF + m * 16;
                        f32x4 v0 = acc[ai][bj][m][0], v1 = acc[ai][bj][m][1];
                        if (MODE != 3) {
#pragma unroll
                            for (int e = 0; e < 4; ++e) { v0[e] = sc_ * __builtin_amdgcn_rcpf(1.f + __expf(-(b0[e] + v0[e]))); v1[e] = sc_ * __builtin_amdgcn_rcpf(1.f + __expf(-(b1[e] + v1[e]))); } }
                        u32x4 w_; w_.x = cvt_pk_bf16(v0[0], v0[1]); w_.y = cvt_pk_bf16(v0[2], v0[3]); w_.z = cvt_pk_bf16(v1[0], v1[1]); w_.w = cvt_pk_bf16(v1[2], v1[3]);
                        *(u32x4*)(Op + (size_t)row * MIXW + c) = w_; }
                asm volatile("" ::: "memory"); }
        }
    }
};
template <bool R_F32> struct EpiResB {
    static constexpr bool PERM = true, AFTER_DRAIN = false;
    bf16_t* XO; const void* R;
    __device__ __forceinline__ void operator()(const f32x4 (&acc)[2][2][4][2], const Unit& u, int, int, int, int) const {
        int t_ = threadIdx.x; asm volatile("" : "+v"(t_)); const int wid_ = __builtin_amdgcn_readfirstlane(t_ >> 6), wr = wid_ >> 2, wc = wid_ & 3, fr = t_ & 15, fq = (t_ >> 4) & 3;
        const int row0 = u.pm * BM + wr * 64 + fr; const int col0 = u.pn * BM + wc * 32 + 8 * fq;
#pragma unroll
        for (int ai = 0; ai < 2; ++ai)
#pragma unroll
            for (int m = 0; m < 4; ++m) { const size_t off = (size_t)(row0 + ai * HALF + m * 16) * DM + col0;
#pragma unroll
                for (int bj = 0; bj < 2; ++bj) { f32x4 v0 = acc[ai][bj][m][0], v1 = acc[ai][bj][m][1];
                    if (R_F32) { const float* rp = (const float*)R + off + bj * HALF; v0 = v0 + *(const f32x4*)rp; v1 = v1 + *(const f32x4*)(rp + 4); }
                    else { const u32x4 rw = *(const u32x4*)((const bf16_t*)R + off + bj * HALF);
                        v0 = v0 + (f32x4){bflo(rw.x), bfhi(rw.x), bflo(rw.y), bfhi(rw.y)}; v1 = v1 + (f32x4){bflo(rw.z), bfhi(rw.z), bflo(rw.w), bfhi(rw.w)}; }
                    u32x4 w; w.x = cvt_pk_bf16(v0[0], v0[1]); w.y = cvt_pk_bf16(v0[2], v0[3]); w.z = cvt_pk_bf16(v1[0], v1[1]); w.w = cvt_pk_bf16(v1[2], v1[3]);
                    *(u32x4*)(XO + off + bj * HALF) = w; }
                if (m & 1) asm volatile("" ::: "memory"); }
    }
};
}

__device__ __forceinline__ void convert_fast(const Ctx& C, const float* W, int K, int N, bf16* WT, int ldk, int mode, int gw0 = -1, int ngw = 0) {
    if (gw0 < 0) { gw0 = C.gw; ngw = C.NGW; }
    constexpr int PITCH = 144;
    LAS unsigned char* T = C.lds + RING_OFF + C.wave * 16384;
    const int nblk = N / 64, nitems = (K / 64) * nblk, lane = C.lane, nq = lane & 15, kg = lane >> 4;
    for (int item = gw0; item < nitems; item += ngw) {
        const int kb = item / nblk, nb = item % nblk, k0 = 64 * kb, n0 = 64 * nb;
        f32x4 v[2][8];
#pragma unroll
        for (int h = 0; h < 2; ++h)
#pragma unroll
            for (int e = 0; e < 8; ++e) v[h][e] = __builtin_nontemporal_load((const f32x4*)(W + (size_t)(k0 + 32 * h + 8 * kg + e) * N + n0 + 4 * nq));
#pragma unroll
        for (int h = 0; h < 2; ++h)
#pragma unroll
            for (int j = 0; j < 4; ++j) { v4u o; o.x = pk2(v[h][0][j], v[h][1][j]); o.y = pk2(v[h][2][j], v[h][3][j]); o.z = pk2(v[h][4][j], v[h][5][j]); o.w = pk2(v[h][6][j], v[h][7][j]);
                *(LAS v4u*)(T + (4 * nq + j) * PITCH + (32 * h + 8 * kg) * 2) = o; }
        LDS_WAIT(); asm volatile("" ::: "memory");
        int d0 = n0;
        if (mode == 1) { d0 = (n0 < DFF) ? (256 * (n0 / 128) + (n0 % 128)) : (256 * ((n0 - DFF) / 128) + 128 + ((n0 - DFF) % 128)); }
#pragma unroll
        for (int s = 0; s < 8; ++s) { const int n = 8 * s + (lane >> 3), kc = lane & 7;
            const v4u o = *(const LAS v4u*)(T + n * PITCH + kc * 16);
            *(v4u*)(WT + (size_t)(d0 + n) * ldk + k0 + 8 * kc) = o; }
        LDS_WAIT(); asm volatile("" ::: "memory");
    }
}

__device__ __forceinline__ void vt_build(const Ctx& C, const bf16* VF, bf16* VT, int gw0, int ngw) {
    constexpr int PITCH = 272;
    LAS unsigned char* T = C.lds + RING_OFF + C.wave * 16384;
    const int lane = C.lane;
    for (int item = gw0; item < BATCH * 24 * 128; item += ngw) {
        const int iblk = item & 127, h = (item >> 7) % 24, b = item / (128 * 24), grp = h >> 3, ld = 2 * grp, d = 1 << ld, Lg = SEQ >> ld;
        const int i0 = iblk * 32, r = i0 / Lg, m0 = i0 % Lg;
#pragma unroll
        for (int s = 0; s < 8; ++s) { const int pi = 4 * s + (lane >> 4); const int pos = (m0 + pi) * d + r;
            const v4u x = *(const v4u*)(VF + (size_t)(b * SEQ + pos) * MIXW + h * 128 + 8 * (lane & 15));
            *(LAS v4u*)(T + pi * PITCH + 16 * (lane & 15)) = x; }
        LDS_WAIT(); asm volatile("" ::: "memory");
#pragma unroll
        for (int s = 0; s < 8; ++s) { const int dim = (s & 1) * 64 + lane, gq = s >> 1;
            unsigned short e[8];
#pragma unroll
            for (int k = 0; k < 8; ++k) e[k] = *(const LAS unsigned short*)(T + (8 * gq + k) * PITCH + dim * 2);
            v4u o; o.x = (unsigned)e[0] | ((unsigned)e[1] << 16); o.y = (unsigned)e[2] | ((unsigned)e[3] << 16); o.z = (unsigned)e[4] | ((unsigned)e[5] << 16); o.w = (unsigned)e[6] | ((unsigned)e[7] << 16);
            *(v4u*)(VT + (size_t)(b * 24 + h) * (128 * SEQ) + (size_t)((iblk * 8 + (dim >> 4)) * 2 + (gq >> 1)) * 256 + (dim & 15) * 16 + (gq & 1) * 8) = o; }
        LDS_WAIT(); asm volatile("" ::: "memory");
    }
}

__device__ __forceinline__ void attn_mfma(const Ctx& C, const bf16* P, const bf16* KB2, const bf16* VT, bf16* CAT) {
    const int lane = C.lane, c = lane & 15, g = lane >> 4;
    const float sc = 0.08838834764831845f * 1.4426950408889634f;
    const int vcu_ = (gridDim.x % 8 == 0) ? (int)((blockIdx.x % 8) * (gridDim.x / 8) + blockIdx.x / 8) : (int)blockIdx.x;
    for (int U = vcu_; U < 512; U += gridDim.x) {
        const int half = U & 1, chunk = (U >> 1) & 15, j = (U >> 5) & 7, b = U >> 8;
        const int r16 = half * 8 + C.wave, base = chunk * 256, qpos = base + 16 * c + r16;
        float m = -1e30f, l = 0.f; f32x4 o[8];
#pragma unroll
        for (int dt = 0; dt < 8; ++dt) o[dt] = (f32x4){0.f, 0.f, 0.f, 0.f};
#pragma unroll
        for (int grp = 0; grp < 3; ++grp) {
            const int ld = 2 * grp, d = 1 << ld, Lg = SEQ >> ld, h = 8 * grp + j, rg = r16 & (d - 1);
            const int mq = qpos >> ld, lo = (mq - 128 > 0) ? (mq - 128) : 0;
            const int m0 = (base + r16) >> ld, m15 = (base + 240 + r16) >> ld;
            const int kstart = (m0 - 128) & ~31, nsteps = ((m15 - kstart) >> 5) + 1;
            bf16x8v qf[4];
            { const bf16* qp = P + (size_t)(b * SEQ + qpos) * LDP + PA_Q + h * 128 + 8 * g;
#pragma unroll
              for (int ks = 0; ks < 4; ++ks) qf[ks] = *(const bf16x8v*)(qp + 32 * ks); }
            const bf16* kbase = KB2 + (size_t)(b * 24 + h) * (128 * SEQ) + (size_t)(rg * (Lg >> 4)) * 2048 + c * 32 + g * 8;
            const bf16* vbase = VT + (size_t)(b * 24 + h) * (128 * SEQ) + (size_t)(rg * (Lg >> 5)) * 4096 + c * 16 + g * 4;
            bf16x8v kc[8], kn[8];
#define ATT_KLOAD(dst, ss) do { int kt_ = (kstart >> 4) + 2 * (ss); kt_ = kt_ < 0 ? 0 : (kt_ > (Lg >> 4) - 2 ? (Lg >> 4) - 2 : kt_);       \
                const bf16* kp_ = kbase + (size_t)kt_ * 2048; \
                _Pragma("unroll") for (int ks = 0; ks < 4; ++ks) { dst[ks] = *(const bf16x8v*)(kp_ + ks * 512); dst[4 + ks] = *(const bf16x8v*)(kp_ + 2048 + ks * 512); } } while (0)
            v2u x0[8], x1[8], y0[8], y1[8];
#define ATT_VLOAD(d0, d1, ss) do { int kbk_ = (kstart >> 5) + (ss); kbk_ = kbk_ < 0 ? 0 : (kbk_ > (Lg >> 5) - 1 ? (Lg >> 5) - 1 : kbk_);       \
                const bf16* vb_ = vbase + (size_t)kbk_ * 4096; \
                _Pragma("unroll") for (int dt = 0; dt < 8; ++dt) { d0[dt] = *(const v2u*)(vb_ + dt * 512); d1[dt] = *(const v2u*)(vb_ + dt * 512 + 256); } } while (0)
            ATT_KLOAD(kc, 0); ATT_VLOAD(x0, x1, 0);
            for (int s = 0; s < nsteps; ++s) {
                const int kb = kstart + 32 * s;
                const int v4a = kb + 4 * g, v4b = kb + 16 + 4 * g;
                ATT_KLOAD(kn, s + 1); ATT_VLOAD(y0, y1, s + 1);
                f32x4 s0 = (f32x4){0.f, 0.f, 0.f, 0.f}, s1 = (f32x4){0.f, 0.f, 0.f, 0.f};
#pragma unroll
                for (int ks = 0; ks < 4; ++ks) { s0 = __builtin_amdgcn_mfma_f32_16x16x32_bf16(kc[ks], qf[ks], s0, 0, 0, 0); s1 = __builtin_amdgcn_mfma_f32_16x16x32_bf16(kc[4 + ks], qf[ks], s1, 0, 0, 0); }
                float t[8]; bool ok[8]; float mx = -1e30f;
#pragma unroll
                for (int r = 0; r < 4; ++r) { const int k0i = v4a + r, k1i = v4b + r; ok[r] = (k0i >= lo) && (k0i <= mq); ok[4 + r] = (k1i >= lo) && (k1i <= mq);
                    t[r] = s0[r] * sc; t[4 + r] = s1[r] * sc; if (ok[r]) mx = fmaxf(mx, t[r]); if (ok[4 + r]) mx = fmaxf(mx, t[4 + r]); }
                mx = fmaxf(mx, __shfl_xor(mx, 16)); mx = fmaxf(mx, __shfl_xor(mx, 32));
                const float mn = fmaxf(m, mx), alpha = __builtin_amdgcn_exp2f(m - mn); m = mn;
                float p[8], ps = 0.f;
#pragma unroll
                for (int r = 0; r < 8; ++r) { p[r] = ok[r] ? __builtin_amdgcn_exp2f(t[r] - mn) : 0.f; ps += p[r]; }
                l = l * alpha + ps;
#pragma unroll
                for (int dt = 0; dt < 8; ++dt) o[dt] = o[dt] * alpha;
                v4u pw; pw.x = pk2(p[0], p[1]); pw.y = pk2(p[2], p[3]); pw.z = pk2(p[4], p[5]); pw.w = pk2(p[6], p[7]);
                const bf16x8v pf = __builtin_bit_cast(bf16x8v, pw);
#pragma unroll
                for (int dt = 0; dt < 8; ++dt) { v4u vw; vw.x = x0[dt].x; vw.y = x0[dt].y; vw.z = x1[dt].x; vw.w = x1[dt].y;
                    o[dt] = __builtin_amdgcn_mfma_f32_16x16x32_bf16(__builtin_bit_cast(bf16x8v, vw), pf, o[dt], 0, 0, 0); }
#pragma unroll
                for (int i = 0; i < 8; ++i) { kc[i] = kn[i]; x0[i] = y0[i]; x1[i] = y1[i]; }
            }
#undef ATT_KLOAD
#undef ATT_VLOAD
        }
        l += __shfl_xor(l, 16); l += __shfl_xor(l, 32);
        const float inv = 1.f / l;
        bf16* op = CAT + (size_t)(b * SEQ + qpos) * A_CAT + j * 128 + 4 * g;
#pragma unroll
        for (int dt = 0; dt < 8; ++dt) { v2u ow; ow.x = pk2(o[dt][0] * inv, o[dt][1] * inv); ow.y = pk2(o[dt][2] * inv, o[dt][3] * inv); *(v2u*)(op + dt * 16) = ow; }
    }
}

namespace pg8 {
struct EpiConvAct {
    static constexpr bool PERM = true, AFTER_DRAIN = false;
    bf16_t* ACT; float* HALO; float* RAWG; float* RAWU; const float* cw; const float* cb;
    __device__ __forceinline__ void operator()(const f32x4 (&acc)[2][2][4][2], const Unit& u, int, int, int, int) const {
        int t_ = threadIdx.x; asm volatile("" : "+v"(t_)); const int wid_ = __builtin_amdgcn_readfirstlane(t_ >> 6), wr = wid_ >> 2, wc = wid_ & 3, fr = t_ & 15, fq = (t_ >> 4) & 3;
        const int c0 = u.pn * HALF + wc * 32 + 8 * fq;
#pragma unroll
        for (int ai = 0; ai < 2; ++ai) {
            const int rb = u.pm * 4 + ai * 2 + wr;
            const int row0 = rb * 64 + fr;
            unsigned pk0[4][2];
#pragma unroll
            for (int n = 0; n < 2; ++n) {
                const f32x4 w0 = *(const f32x4*)(cw + c0 + 4 * n), w1 = *(const f32x4*)(cw + DFF + c0 + 4 * n), w2 = *(const f32x4*)(cw + 2 * DFF + c0 + 4 * n), bb = *(const f32x4*)(cb + c0 + 4 * n);
                float o[4][4];
#pragma unroll
                for (int e = 0; e < 4; ++e) { float g[4], r1[4], r2[4];
#pragma unroll
                    for (int m = 0; m < 4; ++m) { g[m] = acc[ai][0][m][n][e]; r1[m] = dppf<0x121>(g[m]); r2[m] = dppf<0x122>(g[m]); }
#pragma unroll
                    for (int m = 0; m < 4; ++m) { const float p1 = (m > 0 && fr == 0) ? r1[m > 0 ? m - 1 : 0] : r1[m], p2 = (m > 0 && fr < 2) ? r2[m > 0 ? m - 1 : 0] : r2[m];
                        const float gt = bb[e] + w0[e] * p2 + w1[e] * p1 + w2[e] * g[m];
                        o[m][e] = gt * __builtin_amdgcn_rcpf(1.f + __expf(-gt)) * acc[ai][1][m][n][e]; } }
#pragma unroll
                for (int m = 0; m < 4; ++m) { const unsigned wx = cvt_pk_bf16(o[m][0], o[m][1]), wy = cvt_pk_bf16(o[m][2], o[m][3]);
                    if (n == 0) { pk0[m][0] = wx; pk0[m][1] = wy; }
                    else if (m > 0 || fr >= 2) { u32x4 w; w.x = pk0[m][0]; w.y = pk0[m][1]; w.z = wx; w.w = wy; *(u32x4*)(ACT + (size_t)(row0 + 16 * m) * DFF + c0) = w; } }
                asm volatile("" ::: "memory");
            }
            if (fr < 2) { float* pg = RAWG + ((size_t)rb * 2 + fr) * DFF + c0; float* pu = RAWU + ((size_t)rb * 2 + fr) * DFF + c0;
                *(f32x4*)pg = acc[ai][0][0][0]; *(f32x4*)(pg + 4) = acc[ai][0][0][1]; *(f32x4*)pu = acc[ai][1][0][0]; *(f32x4*)(pu + 4) = acc[ai][1][0][1]; }
            if (fr >= 14) { float* ph = HALO + ((size_t)rb * 2 + (fr - 14)) * DFF + c0; *(f32x4*)ph = acc[ai][0][3][0]; *(f32x4*)(ph + 4) = acc[ai][0][3][1]; }
            asm volatile("" ::: "memory");
        }
    }
};
}
__device__ __forceinline__ void convact_fixup(const Ctx& C, const float* HALO, const float* RAWG, const float* RAWU, const float* cw, const float* cb, bf16* ACT) {
    for (int idx = C.gtid; idx < 128 * 2 * (DFF / 4); idx += C.GT) { const int c4 = idx % (DFF / 4), rr = (idx / (DFF / 4)) & 1, rb = idx / (2 * (DFF / 4)), c = 4 * c4;
        const f32x4 g0 = *(const f32x4*)(RAWG + ((size_t)rb * 2 + rr) * DFF + c), uu = *(const f32x4*)(RAWU + ((size_t)rb * 2 + rr) * DFF + c);
        f32x4 gm1 = (f32x4){0.f, 0.f, 0.f, 0.f}, gm2 = (f32x4){0.f, 0.f, 0.f, 0.f};
        const bool has_prev = (rb & 63) != 0;
        if (rr == 0) { if (has_prev) { gm1 = *(const f32x4*)(HALO + ((size_t)(rb - 1) * 2 + 1) * DFF + c); gm2 = *(const f32x4*)(HALO + ((size_t)(rb - 1) * 2 + 0) * DFF + c); } }
        else { gm1 = *(const f32x4*)(RAWG + ((size_t)rb * 2 + 0) * DFF + c); if (has_prev) gm2 = *(const f32x4*)(HALO + ((size_t)(rb - 1) * 2 + 1) * DFF + c); }
        const f32x4 a0 = *(const f32x4*)(cw + c), a1 = *(const f32x4*)(cw + DFF + c), a2 = *(const f32x4*)(cw + 2 * DFF + c), b0 = *(const f32x4*)(cb + c);
        float r[4];
#pragma unroll
        for (int e = 0; e < 4; ++e) { const float gt = b0[e] + a0[e] * gm2[e] + a1[e] * gm1[e] + a2[e] * g0[e]; r[e] = gt * __builtin_amdgcn_rcpf(1.f + __expf(-gt)) * uu[e]; }
        v2u w; w.x = pk2(r[0], r[1]); w.y = pk2(r[2], r[3]);
        *(v2u*)(ACT + (size_t)(rb * 64 + rr) * DFF + c) = w; }
}

constexpr int CH_REC = 15360, CH_G = 12608, CH_AT = 0, CH_RT = 2048, CH_BK = 4096, CH_VT = 8192, CH_NN = 10240, CH_MAK = 11264, CH_TT = 11776, CH_PC = 12288, CH_BON = 12544;
__device__ __forceinline__ void scan_pre(const Ctx& C, const bf16* P, const float* mu, const float* k_k, const float* k_a, const float* r_k,
                                         const bf16* SW, const bf16* SA, const bf16* SV, const bf16* GG, unsigned char* CH) {
    const int lane = C.lane, tl = lane & 15, g = lane >> 4;
    LAS unsigned char* L = C.lds + RING_OFF + C.wave * 16384;
    LAS unsigned short* LAt = (LAS unsigned short*)L; LAS unsigned short* LRt = LAt + 1024; LAS unsigned short* LBt = LAt + 2048; LAS unsigned short* LKt = LAt + 3072;
    LAS float* Mf = (LAS float*)(L + 8192);
    for (int item = C.gw; item < BATCH * RH * 256; item += C.NGW) {
        const int c = item & 255, bh = item >> 8, b = bh / RH, hh = bh % RH, cj = hh * 64 + lane;
        const float mur = mu[PB_R + cj], muk = mu[PB_K + cj], kkj = k_k[cj], kaj = k_a[cj], rkj = r_k[cj];
        unsigned char* rec = CH + (size_t)item * CH_REC;
        float rr[16], k2[16], aa[16], bb[16], ww[16]; unsigned vv[16], gg_[16]; float bon = 0.f;
#pragma unroll
        for (int t = 0; t < 16; ++t) { const int tt = 16 * c + t; const size_t row = (size_t)b * SEQ + tt;
            const bf16* pp = P + row * LDP + cj; const bf16* pq = (tt > 0) ? (pp - LDP) : pp;
            const unsigned pr = pp[PB_R], pk = pp[PB_K], pr1 = pq[PB_R], pk1 = pq[PB_K];
            const size_t o = row * MIXW + cj; const float as = bf2f(SA[o]); ww[t] = bf2f(SW[o]); vv[t] = SV[o]; gg_[t] = GG[o];
            const float rc = bflo(pr), kc = bflo(pk), rp = (tt > 0) ? bflo(pr1) : 0.f, kp = (tt > 0) ? bflo(pk1) : 0.f;
            const float r = rc + (rp - rc) * mur, k = kc + (kp - kc) * muk;
            float kk = k * kkj; const float nrm = sqrtf(wave_sum_dpp(kk * kk)); kk = kk / fmaxf(nrm, 1e-12f);
            rr[t] = r; aa[t] = -kk; bb[t] = kk * as; k2[t] = k * (1.f + (as - 1.f) * kaj);
            const float bt = wave_sum_dpp(r * k2[t] * rkj); if (lane == t) bon = bt; }
        float p = 1.f, cs_ = 0.f, ip[16];
#pragma unroll
        for (int t = 0; t < 16; ++t) { const float pm1 = p; cs_ += ww[t]; p = __expf(cs_); ip[t] = __expf(-cs_);
            LAt[t * 64 + lane] = (unsigned short)f2bf(aa[t] * pm1); LRt[t * 64 + lane] = (unsigned short)f2bf(rr[t] * p);
            LBt[t * 64 + lane] = (unsigned short)f2bf(bb[t] * ip[t]); LKt[t * 64 + lane] = (unsigned short)f2bf(k2[t] * ip[t]); }
#pragma unroll
        for (int gg = 0; gg < 4; ++gg) { v4u o;
            o.x = pk2(bb[4 * gg] * ip[4 * gg] * p, bb[4 * gg + 1] * ip[4 * gg + 1] * p); o.y = pk2(bb[4 * gg + 2] * ip[4 * gg + 2] * p, bb[4 * gg + 3] * ip[4 * gg + 3] * p);
            o.z = pk2(k2[4 * gg] * ip[4 * gg] * p, k2[4 * gg + 1] * ip[4 * gg + 1] * p); o.w = pk2(k2[4 * gg + 2] * ip[4 * gg + 2] * p, k2[4 * gg + 3] * ip[4 * gg + 3] * p);
            *(v4u*)(rec + CH_BK + (lane * 4 + gg) * 16) = o; }
        *(float*)(rec + CH_PC + lane * 4) = p;
#define PKB(a, b) ((a) | ((b) << 16))
        { v4u o0, o1; o0.x = PKB(vv[0], vv[1]); o0.y = PKB(vv[2], vv[3]); o0.z = PKB(vv[4], vv[5]); o0.w = PKB(vv[6], vv[7]); o1.x = PKB(vv[8], vv[9]); o1.y = PKB(vv[10], vv[11]); o1.z = PKB(vv[12], vv[13]); o1.w = PKB(vv[14], vv[15]);
          *(v4u*)(rec + CH_VT + lane * 32) = o0; *(v4u*)(rec + CH_VT + lane * 32 + 16) = o1; }
        { v4u o0, o1; o0.x = PKB(gg_[0], gg_[1]); o0.y = PKB(gg_[2], gg_[3]); o0.z = PKB(gg_[4], gg_[5]); o0.w = PKB(gg_[6], gg_[7]); o1.x = PKB(gg_[8], gg_[9]); o1.y = PKB(gg_[10], gg_[11]); o1.z = PKB(gg_[12], gg_[13]); o1.w = PKB(gg_[14], gg_[15]);
          *(v4u*)(rec + CH_G + lane * 32) = o0; *(v4u*)(rec + CH_G + lane * 32 + 16) = o1; }
        if (lane < 16) *(float*)(rec + CH_BON + lane * 4) = bon;
        LDS_WAIT(); asm volatile("" ::: "memory");
#pragma unroll
        for (int ks = 0; ks < 2; ++ks) { const int j0 = tl * 64 + 32 * ks + 4 * g;
            const v2u a0 = *(const LAS v2u*)(LAt + j0), a1 = *(const LAS v2u*)(LAt + j0 + 16), r0 = *(const LAS v2u*)(LRt + j0), r1 = *(const LAS v2u*)(LRt + j0 + 16);
            v4u oa, orr; oa.x = a0.x; oa.y = a0.y; oa.z = a1.x; oa.w = a1.y; orr.x = r0.x; orr.y = r0.y; orr.z = r1.x; orr.w = r1.y;
            *(v4u*)(rec + CH_AT + tl * 128 + (32 * ks + 8 * g) * 2) = oa; *(v4u*)(rec + CH_RT + tl * 128 + (32 * ks + 8 * g) * 2) = orr; }
        f32x4 mab = (f32x4){0.f, 0.f, 0.f, 0.f}, mak = mab, nbr = mab, nkr = mab;
#pragma unroll
        for (int ks = 0; ks < 2; ++ks) { const int fo = tl * 64 + 32 * ks + 8 * g;
            const bf16x8v fb = *(const LAS bf16x8v*)(LBt + fo), fk = *(const LAS bf16x8v*)(LKt + fo), fa = *(const LAS bf16x8v*)(LAt + fo), fr_ = *(const LAS bf16x8v*)(LRt + fo);
            mab = __builtin_amdgcn_mfma_f32_16x16x32_bf16(fb, fa, mab, 0, 0, 0); mak = __builtin_amdgcn_mfma_f32_16x16x32_bf16(fk, fa, mak, 0, 0, 0);
            nbr = __builtin_amdgcn_mfma_f32_16x16x32_bf16(fb, fr_, nbr, 0, 0, 0); nkr = __builtin_amdgcn_mfma_f32_16x16x32_bf16(fk, fr_, nkr, 0, 0, 0); }
#pragma unroll
        for (int e = 0; e < 4; ++e) { const int s = 4 * g + e; if (!(s < tl)) { mab[e] = 0.f; mak[e] = 0.f; } if (!(s <= tl)) { nbr[e] = 0.f; nkr[e] = 0.f; } Mf[s * 16 + tl] = mab[e]; }
        { v2u o; o.x = pk2(mak[0], mak[1]); o.y = pk2(mak[2], mak[3]); *(v2u*)(rec + CH_MAK + (tl * 16 + 4 * g) * 2) = o;
          v4u n; n.x = pk2(nbr[0], nbr[1]); n.y = pk2(nbr[2], nbr[3]); n.z = pk2(nkr[0], nkr[1]); n.w = pk2(nkr[2], nkr[3]); *(v4u*)(rec + CH_NN + (tl * 4 + g) * 16) = n; }
        LDS_WAIT(); asm volatile("" ::: "memory");
        float Tc[16];
#pragma unroll
        for (int s = 15; s >= 0; --s) { float acc_ = (s == tl) ? 1.f : 0.f;
#pragma unroll
            for (int q = s + 1; q < 16; ++q) acc_ += Mf[s * 16 + q] * Tc[q];
            Tc[s] = acc_; }
        if (g == 0) { v4u o0, o1; o0.x = pk2(Tc[0], Tc[1]); o0.y = pk2(Tc[2], Tc[3]); o0.z = pk2(Tc[4], Tc[5]); o0.w = pk2(Tc[6], Tc[7]); o1.x = pk2(Tc[8], Tc[9]); o1.y = pk2(Tc[10], Tc[11]); o1.z = pk2(Tc[12], Tc[13]); o1.w = pk2(Tc[14], Tc[15]);
            *(v4u*)(rec + CH_TT + tl * 32) = o0; *(v4u*)(rec + CH_TT + tl * 32 + 16) = o1; }
        LDS_WAIT(); asm volatile("" ::: "memory");
    }
}

constexpr int YB_PITCH = 20;


constexpr int SQ_D = 7, SQ_AHEAD = SQ_D - 2, SQ_SLOT = CH_REC, YT_PITCH = 68;
__device__ __forceinline__ void scan_seq2(const Ctx& C, const unsigned char* CH, const float* ln_g, const float* ln_b, bf16* CAT) {
    const int bh = blockIdx.x; if (bh >= BATCH * RH) return;
    const int b = bh / RH, hh = bh % RH, lane = C.lane, w = C.wave, tl = lane & 15, g = lane >> 4;
    LAS unsigned char* ring = C.lds + RING_OFF;
    LAS float* Yb = (LAS float*)(C.lds + RING_OFF + SQ_D * SQ_SLOT);
    const unsigned char* rec0 = CH + (size_t)bh * 256 * CH_REC;
#define SQ_BAR() do { asm volatile("s_waitcnt lgkmcnt(0)" ::: "memory"); __builtin_amdgcn_s_barrier(); asm volatile("" ::: "memory"); } while (0)
    if (w < 4) {
        int pcs[4];
#pragma unroll
        for (int i = 0; i < 4; ++i) { int pidx = 4 * w + i; pcs[i] = (pidx > 14 ? 14 : pidx) * 1024; }
#define SQ_ISSUE(cc) do { const unsigned char* src = rec0 + (size_t)(cc) * CH_REC + lane * 16; LAS unsigned char* dst = ring + ((cc) % SQ_D) * SQ_SLOT; \
            _Pragma("unroll") for (int i = 0; i < 4; ++i) __builtin_amdgcn_global_load_lds((const unsigned*)(src + pcs[i]), (LAS unsigned*)(dst + pcs[i]), 16, 0, 0); } while (0)
#pragma unroll
        for (int cc = 0; cc < SQ_AHEAD; ++cc) SQ_ISSUE(cc);
        f32x4 S[4];
#pragma unroll
        for (int jt = 0; jt < 4; ++jt) S[jt] = (f32x4){0.f, 0.f, 0.f, 0.f};
        const int icol = 16 * w + tl;
        for (int c = 0; c < 256; ++c) {
            if (c + SQ_AHEAD - 1 < 256) asm volatile("s_waitcnt vmcnt(16)" ::: "memory");
            else asm volatile("s_waitcnt vmcnt(0)" ::: "memory");
            SQ_BAR();
            if (c + SQ_AHEAD < 256) SQ_ISSUE(c + SQ_AHEAD);
            const LAS unsigned char* rec = ring + (c % SQ_D) * SQ_SLOT;
            const bf16x8v cAt0 = *(const LAS bf16x8v*)(rec + CH_AT + tl * 128 + (8 * g) * 2), cAt1 = *(const LAS bf16x8v*)(rec + CH_AT + tl * 128 + (32 + 8 * g) * 2);
            const bf16x8v cRt0 = *(const LAS bf16x8v*)(rec + CH_RT + tl * 128 + (8 * g) * 2), cRt1 = *(const LAS bf16x8v*)(rec + CH_RT + tl * 128 + (32 + 8 * g) * 2);
            const bf16x8v cBK0 = *(const LAS bf16x8v*)(rec + CH_BK + ((tl) * 4 + g) * 16), cBK1 = *(const LAS bf16x8v*)(rec + CH_BK + ((16 + tl) * 4 + g) * 16);
            const bf16x8v cBK2 = *(const LAS bf16x8v*)(rec + CH_BK + ((32 + tl) * 4 + g) * 16), cBK3 = *(const LAS bf16x8v*)(rec + CH_BK + ((48 + tl) * 4 + g) * 16);
            const f32x4 cp0 = *(const LAS f32x4*)(rec + CH_PC + (4 * g) * 4), cp1 = *(const LAS f32x4*)(rec + CH_PC + (16 + 4 * g) * 4), cp2 = *(const LAS f32x4*)(rec + CH_PC + (32 + 4 * g) * 4), cp3 = *(const LAS f32x4*)(rec + CH_PC + (48 + 4 * g) * 4);
            const bf16x8v cN = *(const LAS bf16x8v*)(rec + CH_NN + (tl * 4 + g) * 16);
            const v2u cMak = *(const LAS v2u*)(rec + CH_MAK + (tl * 16 + 4 * g) * 2), cT = *(const LAS v2u*)(rec + CH_TT + (tl * 16 + 4 * g) * 2), cV = *(const LAS v2u*)(rec + CH_VT + (icol * 16 + 4 * g) * 2);
            v4u t4; bf16x8v sb0, sb1;
            t4.x = pk2(S[0][0], S[0][1]); t4.y = pk2(S[0][2], S[0][3]); t4.z = pk2(S[1][0], S[1][1]); t4.w = pk2(S[1][2], S[1][3]); sb0 = __builtin_bit_cast(bf16x8v, t4);
            t4.x = pk2(S[2][0], S[2][1]); t4.y = pk2(S[2][2], S[2][3]); t4.z = pk2(S[3][0], S[3][1]); t4.w = pk2(S[3][2], S[3][3]); sb1 = __builtin_bit_cast(bf16x8v, t4);
            t4.x = cMak.x; t4.y = cMak.y; t4.z = 0u; t4.w = 0u; const bf16x8v fMak = __builtin_bit_cast(bf16x8v, t4);
            t4.x = cV.x; t4.y = cV.y; t4.z = 0u; t4.w = 0u; const bf16x8v fV0 = __builtin_bit_cast(bf16x8v, t4);
            t4.x = cT.x; t4.y = cT.y; t4.z = 0u; t4.w = 0u; const bf16x8v fT = __builtin_bit_cast(bf16x8v, t4);
            f32x4 Z = (f32x4){0.f, 0.f, 0.f, 0.f};
            Z = __builtin_amdgcn_mfma_f32_16x16x32_bf16(fMak, fV0, Z, 0, 0, 0);
            Z = __builtin_amdgcn_mfma_f32_16x16x32_bf16(cAt0, sb0, Z, 0, 0, 0);
            Z = __builtin_amdgcn_mfma_f32_16x16x32_bf16(cAt1, sb1, Z, 0, 0, 0);
            f32x4 Y = (f32x4){0.f, 0.f, 0.f, 0.f};
            Y = __builtin_amdgcn_mfma_f32_16x16x32_bf16(cRt0, sb0, Y, 0, 0, 0);
            Y = __builtin_amdgcn_mfma_f32_16x16x32_bf16(cRt1, sb1, Y, 0, 0, 0);
            t4.x = pk2(Z[0], Z[1]); t4.y = pk2(Z[2], Z[3]); t4.z = 0u; t4.w = 0u;
            f32x4 U = (f32x4){0.f, 0.f, 0.f, 0.f};
            U = __builtin_amdgcn_mfma_f32_16x16x32_bf16(fT, __builtin_bit_cast(bf16x8v, t4), U, 0, 0, 0);
            t4.x = pk2(U[0], U[1]); t4.y = pk2(U[2], U[3]); t4.z = cV.x; t4.w = cV.y; const bf16x8v buv = __builtin_bit_cast(bf16x8v, t4);
            S[0] = S[0] * cp0; S[1] = S[1] * cp1; S[2] = S[2] * cp2; S[3] = S[3] * cp3;
            S[0] = __builtin_amdgcn_mfma_f32_16x16x32_bf16(cBK0, buv, S[0], 0, 0, 0); S[1] = __builtin_amdgcn_mfma_f32_16x16x32_bf16(cBK1, buv, S[1], 0, 0, 0);
            S[2] = __builtin_amdgcn_mfma_f32_16x16x32_bf16(cBK2, buv, S[2], 0, 0, 0); S[3] = __builtin_amdgcn_mfma_f32_16x16x32_bf16(cBK3, buv, S[3], 0, 0, 0);
            Y = __builtin_amdgcn_mfma_f32_16x16x32_bf16(cN, buv, Y, 0, 0, 0);
#pragma unroll
            for (int e = 0; e < 4; ++e) Yb[(c & 1) * 16 * YT_PITCH + (4 * g + e) * YT_PITCH + icol] = Y[e];
        }
        SQ_BAR();
#undef SQ_ISSUE
    } else {
        const int pw = w - 4, tq = lane >> 4, iq = lane & 15, tt = 4 * pw + tq, cj = hh * 64 + 4 * iq;
        const f32x4 lng = *(const f32x4*)(ln_g + cj), lnb = *(const f32x4*)(ln_b + cj);
        for (int c = 0; c <= 256; ++c) {
            SQ_BAR();
            if (c > 0) { const LAS unsigned char* rec = ring + ((c - 1) % SQ_D) * SQ_SLOT;
                const f32x4 y4 = *(const LAS f32x4*)(Yb + ((c - 1) & 1) * 16 * YT_PITCH + tt * YT_PITCH + 4 * iq);
                const float bo = *(const LAS float*)(rec + CH_BON + tt * 4);
                float vv[4], gv[4];
#pragma unroll
                for (int e = 0; e < 4; ++e) { vv[e] = bf2f(*(const LAS unsigned short*)(rec + CH_VT + ((4 * iq + e) * 16 + tt) * 2)); gv[e] = bf2f(*(const LAS unsigned short*)(rec + CH_G + ((4 * iq + e) * 16 + tt) * 2)); }
                const float s1 = row16_sum((y4[0] + y4[1]) + (y4[2] + y4[3])), s2 = row16_sum((y4[0] * y4[0] + y4[1] * y4[1]) + (y4[2] * y4[2] + y4[3] * y4[3]));
                const float mean = s1 * (1.f / 64.f), var = fmaxf(s2 * (1.f / 64.f) - mean * mean, 0.f), rstd = __builtin_amdgcn_rsqf(var + GN_EPS);
                float o[4];
#pragma unroll
                for (int e = 0; e < 4; ++e) o[e] = ((y4[e] - mean) * rstd * lng[e] + lnb[e] + bo * vv[e]) * gv[e];
                const size_t row = (size_t)b * SEQ + 16 * (c - 1) + tt;
                v2u ow; ow.x = pk2(o[0], o[1]); ow.y = pk2(o[2], o[3]); *(v2u*)(CAT + row * DM + cj) = ow; }
        }
    }
#undef SQ_BAR
}

__device__ __forceinline__ void xattn_lds(const Ctx& C, const bf16* P, int cqoff, const bf16* MEMKV, const bf16* MEMVT, bf16* CAT, int ldc, int catoff, int u0, int ustride) {
    constexpr int KP = 528, VP = 272;
    const int lane = C.lane, w = C.wave, c = lane & 15, g = lane >> 4, tid = C.tid;
    LAS unsigned char* Ls = C.lds + RING_OFF;
    for (int u = u0; u < 256; u += ustride) {
        const int b = u >> 7, xh = (u >> 5) & 3, qb = u & 31;
        const int qrow = b * SEQ + qb * 128 + w * 16 + c;
        bf16x8v qf[8];
        { const bf16* qp = P + (size_t)qrow * LDP + cqoff + xh * 256 + 8 * g;
#pragma unroll
          for (int ks = 0; ks < 8; ++ks) qf[ks] = *(const bf16x8v*)(qp + 32 * ks); }
        f32x4 s[16];
#pragma unroll
        for (int kt = 0; kt < 16; ++kt) s[kt] = (f32x4){0.f, 0.f, 0.f, 0.f};
#pragma unroll
        for (int half = 0; half < 2; ++half) {
            v4u stg[8];
#pragma unroll
            for (int it = 0; it < 8; ++it) { const int idx = it * 512 + tid, row = idx >> 5, c16 = idx & 31;
                stg[it] = *(const v4u*)(MEMKV + (size_t)(b * 256 + half * 128 + row) * 2048 + xh * 256 + c16 * 8); }
            __syncthreads();
#pragma unroll
            for (int it = 0; it < 8; ++it) { const int idx = it * 512 + tid, row = idx >> 5, c16 = idx & 31; *(LAS v4u*)(Ls + row * KP + c16 * 16) = stg[it]; }
            __syncthreads();
#pragma unroll
            for (int kt = 0; kt < 8; ++kt) {
#pragma unroll
                for (int ks = 0; ks < 8; ++ks) { const bf16x8v kf = *(const LAS bf16x8v*)(Ls + (16 * kt + c) * KP + (32 * ks + 8 * g) * 2);
                    s[8 * half + kt] = __builtin_amdgcn_mfma_f32_16x16x32_bf16(kf, qf[ks], s[8 * half + kt], 0, 0, 0); }
                asm volatile("" ::: "memory"); }
        }
        float m = -1e30f;
#pragma unroll
        for (int kt = 0; kt < 16; ++kt) m = fmaxf(fmaxf(m, fmaxf(s[kt][0], s[kt][1])), fmaxf(s[kt][2], s[kt][3]));
        m = fmaxf(m, __shfl_xor(m, 16)); m = fmaxf(m, __shfl_xor(m, 32));
        float l = 0.f; const float sc = 0.0625f * 1.4426950408889634f;
        bf16x8v pf[8];
#pragma unroll
        for (int kk = 0; kk < 8; ++kk) { float p[8];
#pragma unroll
            for (int r = 0; r < 4; ++r) { p[r] = __builtin_amdgcn_exp2f((s[2 * kk][r] - m) * sc); p[4 + r] = __builtin_amdgcn_exp2f((s[2 * kk + 1][r] - m) * sc); }
#pragma unroll
            for (int r = 0; r < 8; ++r) l += p[r];
            v4u pw; pw.x = pk2(p[0], p[1]); pw.y = pk2(p[2], p[3]); pw.z = pk2(p[4], p[5]); pw.w = pk2(p[6], p[7]);
            pf[kk] = __builtin_bit_cast(bf16x8v, pw); }
        l += __shfl_xor(l, 16); l += __shfl_xor(l, 32);
        const float inv = 1.f / l;
        f32x4 o[16];
#pragma unroll
        for (int dt = 0; dt < 16; ++dt) o[dt] = (f32x4){0.f, 0.f, 0.f, 0.f};
#pragma unroll
        for (int half = 0; half < 2; ++half) {
            v4u stg[8];
#pragma unroll
            for (int it = 0; it < 8; ++it) { const int idx = it * 512 + tid, key = idx >> 5, d8 = idx & 31;
                stg[it] = *(const v4u*)(MEMKV + (size_t)(b * 256 + half * 128 + key) * 2048 + 1024 + xh * 256 + d8 * 8); }
            __syncthreads();
#pragma unroll
            for (int it = 0; it < 8; ++it) { const int idx = it * 512 + tid, key = idx >> 5, d8 = idx & 31;
#pragma unroll
                for (int e = 0; e < 8; ++e) { const unsigned wv = stg[it][e >> 1]; *(LAS unsigned short*)(Ls + (8 * d8 + e) * VP + key * 2) = (unsigned short)((e & 1) ? (wv >> 16) : (wv & 0xffffu)); } }
            __syncthreads();
#pragma unroll
            for (int dt = 0; dt < 16; ++dt) {
#pragma unroll
                for (int kk = 0; kk < 4; ++kk) { const LAS unsigned char* vp = Ls + (16 * dt + c) * VP + (32 * kk + 4 * g) * 2;
                    const v2u lo = *(const LAS v2u*)vp, hi = *(const LAS v2u*)(vp + 32);
                    v4u vw; vw.x = lo.x; vw.y = lo.y; vw.z = hi.x; vw.w = hi.y;
                    o[dt] = __builtin_amdgcn_mfma_f32_16x16x32_bf16(__builtin_bit_cast(bf16x8v, vw), pf[4 * half + kk], o[dt], 0, 0, 0); }
                if (dt & 1) asm volatile("" ::: "memory"); }
        }
        bf16* op = CAT + (size_t)qrow * ldc + catoff + xh * 256 + 4 * g;
#pragma unroll
        for (int dt = 0; dt < 16; ++dt) { v2u ow; ow.x = pk2(o[dt][0] * inv, o[dt][1] * inv); ow.y = pk2(o[dt][2] * inv, o[dt][3] * inv); *(v2u*)(op + dt * 16) = ow; }
    }
}

namespace pg8 {
struct EpiAin {
    static constexpr bool PERM = true, AFTER_DRAIN = false;
    bf16_t* P; bf16_t* VF; const float* ROPE; bf16_t* KB2;
    __device__ __forceinline__ void operator()(const f32x4 (&acc)[2][2][4][2], const Unit& u, int, int, int, int) const {
        int t_ = threadIdx.x; asm volatile("" : "+v"(t_)); const int wid_ = __builtin_amdgcn_readfirstlane(t_ >> 6), wr = wid_ >> 2, wc = wid_ & 3, fr = t_ & 15, fq = (t_ >> 4) & 3;
        const int row0 = u.pm * BM + wr * 64 + fr; const int colt = u.pn * BM + wc * 32 + 8 * fq;
        const bool is_v = (u.pn >= 24 && u.pn < 36), is_k = (u.pn >= 12 && u.pn < 24), rot = (u.pn < 24) && (wc == 0);
        bf16_t* base = is_v ? (VF + (colt - PA_V)) : (P + colt); const int ldo = is_v ? MIXW : LDP;
#pragma unroll
        for (int ai = 0; ai < 2; ++ai)
#pragma unroll
            for (int m = 0; m < 4; ++m) { const int row = row0 + ai * HALF + m * 16;
                f32x4 cs[4];
                if (rot) { const float* tp = ROPE + ((size_t)row * 16 + 8 * (fq & 1)) * 2;
#pragma unroll
                    for (int q4 = 0; q4 < 4; ++q4) cs[q4] = *(const f32x4*)(tp + 4 * q4); }
#pragma unroll
                for (int bj = 0; bj < 2; ++bj) { f32x4 v0 = acc[ai][bj][m][0], v1 = acc[ai][bj][m][1];
                    if (rot) { float x[8] = {v0[0], v0[1], v0[2], v0[3], v1[0], v1[1], v1[2], v1[3]};
#pragma unroll
                        for (int e = 0; e < 8; ++e) { const float other = __shfl_xor(x[e], 32); const float cc = cs[e >> 1][2 * (e & 1)], ss = cs[e >> 1][2 * (e & 1) + 1];
                            x[e] = (fq < 2) ? (x[e] * cc - other * ss) : (x[e] * cc + other * ss); }
                        v0 = (f32x4){x[0], x[1], x[2], x[3]}; v1 = (f32x4){x[4], x[5], x[6], x[7]}; }
                    u32x4 w; w.x = cvt_pk_bf16(v0[0], v0[1]); w.y = cvt_pk_bf16(v0[2], v0[3]); w.z = cvt_pk_bf16(v1[0], v1[1]); w.w = cvt_pk_bf16(v1[2], v1[3]);
                    if (is_k) { const int hk = (u.pn - 12) * 2 + bj, ldk_ = 2 * (hk >> 3), tt = row & (SEQ - 1), idx = (tt & ((1 << ldk_) - 1)) * (SEQ >> ldk_) + (tt >> ldk_);
                        *(u32x4*)(KB2 + (size_t)((row >> 12) * 24 + hk) * (128 * SEQ) + (size_t)(idx >> 4) * 2048 + wc * 512 + (idx & 15) * 32 + fq * 8) = w; }
                    else *(u32x4*)(base + (size_t)row * ldo + bj * HALF) = w; }
                asm volatile("" ::: "memory"); }
    }
};
}
constexpr int N_PHASES = 24;
#ifndef REP_CONV
#define REP_CONV 1
#endif
#ifndef REP_ATT
#define REP_ATT 1
#endif
#ifndef REP_SCAN
#define REP_SCAN 1
#endif
#ifndef REP_CACT
#define REP_CACT 1
#endif
#ifndef REP_SONLY
#define REP_SONLY 1
#endif
#ifndef REP_SPRE
#define REP_SPRE 1
#endif
#ifndef REP_LORA
#define REP_LORA 1
#endif
#ifndef REP_UP
#define REP_UP 1
#endif
struct Args { const void* in[30]; float* out; unsigned char* ws; int ph_lo, ph_hi; };
__global__ void __launch_bounds__(NTHREADS, 2) mk_fwd(Args args) {
    extern __shared__ __attribute__((aligned(16))) unsigned char lds_raw[];
    LAS unsigned char* const ldsb = (LAS unsigned char*)lds_raw;
#define MKCTX() Ctx C; { int t_ = threadIdx.x; asm volatile("" : "+v"(t_)); int b_ = blockIdx.x; asm volatile("" : "+s"(b_)); C.lds = ldsb; C.tid = t_; C.lane = t_ & 63; C.wave = __builtin_amdgcn_readfirstlane(t_ >> 6); \
        C.gw = b_ * NWAVES + C.wave; C.NGW = gridDim.x * NWAVES; C.gtid = b_ * NTHREADS + t_; C.GT = gridDim.x * NTHREADS; }
    const int G = gridDim.x, bx = blockIdx.x;
    unsigned char* ws = args.ws;
    gu32* ctl = (gu32*)(ws + WS_CTL);
    volatile LAS unsigned* MISC = (volatile LAS unsigned*)(ldsb + MISC_OFF);
    for (int u = threadIdx.x; u < (LDS_BYTES - LDSCTL_OFF) / 4; u += NTHREADS) ((LAS unsigned*)(ldsb + LDSCTL_OFF))[u] = 0u;
    __syncthreads();
    const int lo = args.ph_lo, hi = args.ph_hi;
    const bool multi = (hi - lo) > 1;
    XcdBarrier bar; bar.bar = (unsigned*)(ctl + CW_BAR); bar.x = 0; bar.st = nullptr;
    if (multi) bar = xcd_barrier_post((unsigned*)(ctl + CW_BAR), MISC + 8);
#ifdef ONLY_PH
#define IN(k) ((k) == ONLY_PH && lo <= (k) && (k) < hi)
#else
#define IN(k) (lo <= (k) && (k) < hi)
#endif
#define SEAM(k) do { if (IN(k) && IN((k) + 1)) xcd_barrier(bar); } while (0)

    constexpr size_t WUP_L = (size_t)DFF2 * DM, WDOWN_L = (size_t)DM * DFF;
#define CAS __attribute__((address_space(4)))
#define KARG_DECL() const CAS char* ka_ = (const CAS char*)__builtin_amdgcn_kernarg_segment_ptr(); asm volatile("" : "+s"(ka_))
#define INF(k) (*(const float* const CAS*)(ka_ + 8 * (k)))
#define WSB(off) ((bf16*)(ws + (off)))
#define WSF(off) ((float*)(ws + (off)))
#define GEMM_BF16(Ap, lda_, Btp, ldb_, M_, N_, K_, Op, ldc_) do { pg8::Gemm g{(const pg8::bf16_t*)(Ap), (const pg8::bf16_t*)(Btp), (M_), (N_), (K_), (lda_), (ldb_)}; \
        pg8::StaticOrder S; S.init((M_), (N_), G, bx); pg8::EpiBf16P E{(pg8::bf16_t*)(Op), (ldc_)}; \
        pg8::gemm_phase<pg8::EpiBf16P, pg8::StaticOrder, true>(ldsb + RING_OFF, g, S, E); } while (0)
#define GEMM_RESB(RF32, Ap, lda_, Btp, K_, Rp) do { pg8::Gemm g{(const pg8::bf16_t*)(Ap), (const pg8::bf16_t*)(Btp), NTOK, DM, (K_), (lda_), (K_)}; \
        pg8::StaticOrder S; S.init(NTOK, DM, G, bx); pg8::EpiResB<RF32> E{(pg8::bf16_t*)WSB(WS_X), (const void*)(Rp)}; \
        pg8::gemm_phase<pg8::EpiResB<RF32>, pg8::StaticOrder, true>(ldsb + RING_OFF, g, S, E); } while (0)
#define GEMM_F32(Ap, lda_, Btp, ldb_, M_, N_, K_, Op, Rp, ldc_) do { pg8::Gemm g{(const pg8::bf16_t*)(Ap), (const pg8::bf16_t*)(Btp), (M_), (N_), (K_), (lda_), (ldb_)}; \
        pg8::StaticOrder S; S.init((M_), (N_), G, bx); pg8::EpiF32 E{(Op), (Rp), (ldc_)}; \
        pg8::gemm_phase<pg8::EpiF32, pg8::StaticOrder, true>(ldsb + RING_OFF, g, S, E); } while (0)

#define GEMM_CONVACT(Ap, Btp, cwp, cbp) do { pg8::Gemm g{(const pg8::bf16_t*)(Ap), (const pg8::bf16_t*)(Btp), NTOK, DFF2, DM, DM, DM}; \
        pg8::StaticOrder S; S.init(NTOK, DFF2, G, bx); pg8::EpiConvAct E{(pg8::bf16_t*)WSB(WS_ACT), WSF(WS_HALO), WSF(WS_RAWG), WSF(WS_RAWU), (cwp), (cbp)}; \
        pg8::gemm_phase<pg8::EpiConvAct, pg8::StaticOrder, true>(ldsb + RING_OFF, g, S, E); } while (0)

    if (IN(0)) { MKCTX(); KARG_DECL();
        for (int rep_ = 0; rep_ < REP_CONV; ++rep_) {
        convert_fast(C, INF(4), DM, 2048, WSB(WS_WKV), DM, 0);
        convert_fast(C, INF(6), DM, A_IN, WSB(WS_WAIN), DM, 0);
        convert_fast(C, INF(7), A_CAT, DM, WSB(WS_WAOUT), A_CAT, 0);
        convert_fast(C, INF(9), DM, B_IN, WSB(WS_WBIN), DM, 0);
        convert_job(C, INF(12), 128, MIXW, WSB(WS_WLW), 256, 0, 256, 0);
        convert_job(C, INF(14), 128, MIXW, WSB(WS_WLA), 256, 128, 256, 0);
        convert_job(C, INF(16), 96, MIXW, WSB(WS_WLV), 256, 0, 256, 0);
        convert_job(C, INF(17), 480, MIXW, WSB(WS_WLG), 512, 0, 512, 0);
        convert_fast(C, INF(25), DM, DFF2, WSB(WS_WUP), DM, 1);
        convert_fast(C, INF(28), DFF, DM, WSB(WS_WDOWN), DFF, 0);
        }
        rope_table(C, (const int*)INF(2), WSF(WS_ROPE));
        rmsnorm_rows<false>(C, INF(1), INF(3), WSB(WS_MEMN), NMEM);
        rmsnorm_rows<false>(C, INF(0), INF(5), WSB(WS_H), NTOK);
    }
    SEAM(0);
    if (IN(2)) { pg8::Gemm g{(const pg8::bf16_t*)WSB(WS_H), (const pg8::bf16_t*)WSB(WS_WAIN), NTOK, A_IN, DM, DM, DM};
        pg8::StaticOrder S; S.init(NTOK, A_IN, G, bx); pg8::EpiAin E{(pg8::bf16_t*)WSB(WS_P), (pg8::bf16_t*)WSB(WS_VFIRST), WSF(WS_ROPE), (pg8::bf16_t*)WSB(WS_Y)};
        pg8::gemm_phase<pg8::EpiAin, pg8::StaticOrder, true>(ldsb + RING_OFF, g, S, E); }
    SEAM(2);
    if (IN(3)) {
        if (bx < 16) GEMM_BF16(WSB(WS_MEMN), DM, WSB(WS_WKV), DM, NMEM, 2048, DM, WSB(WS_MEMKV), 2048);
        else { MKCTX(); KARG_DECL(); vt_build(C, WSB(WS_VFIRST), WSB(WS_VT), (bx - 16) * NWAVES + C.wave, (G - 16) * NWAVES);
            convert_fast(C, INF(28) + WDOWN_L, DFF, DM, WSB(WS_WDOWN) + WDOWN_L, DFF, 0, (bx - 16) * NWAVES + C.wave, (G - 16) * NWAVES); }
    }
    SEAM(3);
    if (IN(4)) for (int rep_ = 0; rep_ < REP_ATT; ++rep_) { MKCTX(); KARG_DECL(); attn_mfma(C, WSB(WS_P), WSB(WS_Y), WSB(WS_VT), WSB(WS_CAT)); xattn_lds(C, WSB(WS_P), PA_CQ, WSB(WS_MEMKV), WSB(WS_MEMKV), WSB(WS_CAT), A_CAT, A_OUTW, (G % 8 == 0) ? (bx % 8) * (G / 8) + bx / 8 : bx, G); }
    SEAM(4);
    if (IN(6)) { KARG_DECL(); GEMM_RESB(true, WSB(WS_CAT), A_CAT, WSB(WS_WAOUT), A_CAT, INF(0)); }
    SEAM(6);
    if (IN(7)) { MKCTX(); KARG_DECL(); rmsnorm_rows_b<false>(C, WSB(WS_X), INF(24), WSB(WS_H), NTOK); }
    SEAM(7);
    if (IN(8)) { KARG_DECL(); for (int rep_ = 0; rep_ < REP_UP; ++rep_) GEMM_CONVACT(WSB(WS_H), WSB(WS_WUP), INF(26), INF(27)); }
    SEAM(8);
    if (IN(9)) { MKCTX(); KARG_DECL(); convact_fixup(C, WSF(WS_HALO), WSF(WS_RAWG), WSF(WS_RAWU), INF(26), INF(27), WSB(WS_ACT)); }
    SEAM(9);
    if (IN(10)) GEMM_RESB(false, WSB(WS_ACT), DFF, WSB(WS_WDOWN), DFF, WSB(WS_X));
    SEAM(10);
    if (IN(11)) { MKCTX(); KARG_DECL(); rmsnorm_rows_b<false>(C, WSB(WS_X), INF(8), WSB(WS_H), NTOK); }
    SEAM(11);
    if (IN(12)) GEMM_BF16(WSB(WS_H), DM, WSB(WS_WBIN), DM, NTOK, B_IN_PAD, DM, WSB(WS_P), LDP);
    SEAM(12);
    if (IN(13)) for (int rl_ = 0; rl_ < REP_LORA; ++rl_) { MKCTX(); KARG_DECL(); prep_b1(C, WSB(WS_P), INF(10), WSB(WS_LA)); }
    SEAM(13);
    if (IN(14)) for (int rl_ = 0; rl_ < REP_LORA; ++rl_) { KARG_DECL();
#define GEMM_LORA(MODE, Ap, Btp, K_, Op, biasp) GEMM_LORA2(MODE, MIXW, Ap, Btp, K_, Op, biasp, (pg8::bf16_t*)nullptr, (const float*)nullptr)
#define GEMM_LORA2(MODE, N_, Ap, Btp, K_, Op, biasp, O2p, bias2p) do { int kv_ = (K_); asm volatile("" : "+s"(kv_)); pg8::Gemm g{(const pg8::bf16_t*)(Ap), (const pg8::bf16_t*)(Btp), NTOK, (N_), kv_, 1024, kv_}; \
        pg8::StaticOrder S; S.init(NTOK, (N_), G, bx); pg8::EpiLora<MODE> E{(pg8::bf16_t*)(Op), (biasp), (const pg8::bf16_t*)WSB(WS_P), INF(10), (const pg8::bf16_t*)WSB(WS_VFIRST), (pg8::bf16_t*)(O2p), (bias2p)}; \
        pg8::gemm_phase<pg8::EpiLora<MODE>, pg8::StaticOrder, true>(ldsb + RING_OFF, g, S, E); } while (0)
        GEMM_LORA2(4, 2 * MIXW, WSB(WS_LA), WSB(WS_WLW), 256, WSF(WS_SW), INF(11), WSF(WS_SA), INF(13));
        GEMM_LORA(2, WSB(WS_LA) + 256, WSB(WS_WLV), 256, WSF(WS_SV), INF(15));
        GEMM_LORA(3, WSB(WS_LA) + 512, WSB(WS_WLG), 512, WSF(WS_G), (const float*)nullptr);
    }
    SEAM(14);
    if (IN(15)) for (int rp_ = 0; rp_ < REP_SPRE; ++rp_) { MKCTX(); KARG_DECL(); scan_pre(C, WSB(WS_P), INF(10), INF(18), INF(19), INF(20), WSB(WS_SW), WSB(WS_SA), WSB(WS_SV), WSB(WS_G), ws + WS_CH); }
    SEAM(15);
    if (IN(17)) for (int rep_ = 0; rep_ < REP_SCAN; ++rep_) { MKCTX(); KARG_DECL();
        if (bx < BATCH * RH) for (int rs_ = 0; rs_ < REP_SONLY; ++rs_) scan_seq2(C, ws + WS_CH, INF(21), INF(22), WSB(WS_CAT));
        else { xattn_lds(C, WSB(WS_P), PB_CQ, WSB(WS_MEMKV), WSB(WS_MEMKV), WSB(WS_CAT), DM, MIXW, bx - BATCH * RH, G - BATCH * RH);
            __syncthreads();
            const int cgw = (bx - BATCH * RH) * NWAVES + C.wave, cng = (G - BATCH * RH) * NWAVES;
            convert_fast(C, INF(23), DM, DM, WSB(WS_WBOUT), DM, 0, cgw, cng);
            convert_fast(C, INF(25) + WUP_L, DM, DFF2, WSB(WS_WUP) + WUP_L, DM, 1, cgw, cng);
            }
    }
    SEAM(17);
    if (IN(18)) GEMM_RESB(false, WSB(WS_CAT), DM, WSB(WS_WBOUT), DM, WSB(WS_X));
    SEAM(18);
    if (IN(19)) { MKCTX(); KARG_DECL(); rmsnorm_rows_b<false>(C, WSB(WS_X), INF(24) + DM, WSB(WS_H), NTOK); }
    SEAM(19);
    if (IN(20)) { KARG_DECL(); for (int rep_ = 0; rep_ < REP_UP; ++rep_) GEMM_CONVACT(WSB(WS_H), WSB(WS_WUP) + WUP_L, INF(26) + 3 * DFF, INF(27) + DFF); }
    SEAM(20);
    if (IN(21)) { MKCTX(); KARG_DECL(); convact_fixup(C, WSF(WS_HALO), WSF(WS_RAWG), WSF(WS_RAWU), INF(26) + 3 * DFF, INF(27) + DFF, WSB(WS_ACT)); }
    SEAM(21);
    if (IN(22)) GEMM_RESB(false, WSB(WS_ACT), DFF, WSB(WS_WDOWN) + WDOWN_L, DFF, WSB(WS_X));
    SEAM(22);
    if (IN(23)) { MKCTX(); KARG_DECL(); rmsnorm_rows_b<true>(C, WSB(WS_X), INF(29), (void*)INF(30), NTOK); }
#undef IN
#undef SEAM
}

#ifndef MK_ONE_LAUNCH
#define MK_ONE_LAUNCH 0
#endif
extern "C" void kernel_launch(void* const* d_in, const int* in_sizes, int n_in, void* d_out, int out_size, void* d_ws, size_t ws_size, hipStream_t stream) {
    static int grid = 0;
    if (grid == 0) {
        if (n_in != 30 || out_size != NTOK * DM || ws_size < WS_END) { fprintf(stderr, "kernel_launch: unexpected shapes: n_in %d out %d ws %zu (need %zu)\n", n_in, out_size, ws_size, (size_t)WS_END); grid = -1; return; }
        int dev = 0, cus = 0, per_cu = 0;
        if (hipGetDevice(&dev) != hipSuccess || hipDeviceGetAttribute(&cus, hipDeviceAttributeMultiprocessorCount, dev) != hipSuccess) { grid = -1; return; }
        if (hipFuncSetAttribute((const void*)mk_fwd, hipFuncAttributeMaxDynamicSharedMemorySize, LDS_BYTES) != hipSuccess) { fprintf(stderr, "kernel_launch: hipFuncSetAttribute failed\n"); grid = -1; return; }
        if (hipOccupancyMaxActiveBlocksPerMultiprocessor(&per_cu, (const void*)mk_fwd, NTHREADS, LDS_BYTES) != hipSuccess || per_cu < 1) { fprintf(stderr, "kernel_launch: occupancy query says %d\n", per_cu); }
        (void)hipGetLastError();
        grid = cus;
    }
    if (grid < 0) return;
    (void)hipMemsetAsync((char*)d_ws + WS_CTL, 0, CTL_ZERO_BYTES, stream);
    Args a{};
    for (int i = 0; i < 30; ++i) a.in[i] = d_in[i];
    a.out = (float*)d_out; a.ws = (unsigned char*)d_ws;
#if MK_ONE_LAUNCH
    a.ph_lo = 0; a.ph_hi = N_PHASES;
    hipLaunchKernelGGL(mk_fwd, dim3(grid), dim3(NTHREADS), LDS_BYTES, stream, a);
#else
    for (int p = 0; p < N_PHASES; ++p) { a.ph_lo = p; a.ph_hi = p + 1; hipLaunchKernelGGL(mk_fwd, dim3(grid), dim3(NTHREADS), LDS_BYTES, stream, a); }
#endif
}
```

```cpp
#include <hip/hip_runtime.h>
#include <cstdio>
#include <cstdint>
#define MK_ONE_LAUNCH 1
namespace pg8 {
#define PG8_LAS __attribute__((address_space(3)))
typedef unsigned short bf16_t;
typedef short bf16x8 __attribute__((ext_vector_type(8)));
typedef float f32x4 __attribute__((ext_vector_type(4)));
typedef unsigned u32x4 __attribute__((ext_vector_type(4)));
constexpr int BM = 256, BK = 64, HALF = 128, HTB = HALF * BK * 2  , STAGE_BYTES = 8 * HTB, NXCD = 8, WGM = 8;

__host__ __device__ __forceinline__ int lds_byte(int r, int c) { const int st = (r >> 4) * 2 + (c >> 5), rr = r & 15, cc = c & 31, ob = rr * 64 + cc * 2; return st * 1024 + (ob ^ (((ob >> 9) & 1) << 5)); }
__host__ __device__ __forceinline__ void stage_rc(int b, int& R, int& C) { const int st = b / 1024, sb = b % 1024, swz = sb ^ (((sb >> 9) & 1) << 5); R = (st >> 1) * 16 + swz / 64; C = (st & 1) * 32 + (swz % 64) / 2; }
__host__ __device__ __forceinline__ int perm32(int rho) { const int n = rho >> 4, i = rho & 15; return 8 * (i >> 2) + 4 * n + (i & 3); }

struct Unit { int pm, pn; };
struct Gemm { const bf16_t* A; const bf16_t* Bt; int M, N, K, lda, ldb; };

struct StaticOrder {
    int nM, nN, nwg, G, c;
    __host__ __device__ void init(int M, int N, int G_, int c_) { nM = M / BM; nN = N / BM; nwg = nM * nN; G = G_; c = c_; }
    __host__ __device__ bool next(int i, Unit& u) const {
        const long L = (long)i * G + c; if (L >= nwg) return false;
        int wgid = (int)L; { const int q = nwg / NXCD, r = nwg % NXCD, xcd = wgid % NXCD, off = wgid / NXCD; wgid = (xcd < r ? xcd * (q + 1) : r * (q + 1) + (xcd - r) * q) + off; }
        const int nig = WGM * nN, gid = wgid / nig, fm = gid * WGM, gsz = (nM - fm) < WGM ? (nM - fm) : WGM;
        u.pm = fm + ((wgid % nig) % gsz); u.pn = (wgid % nig) / gsz; return true;
    }
    __device__ __forceinline__ void a_ready(const Unit&) const {}
    __device__ __forceinline__ void done(const Unit&) const {}
};

__device__ __forceinline__ unsigned cvt_pk_bf16(float lo, float hi) { unsigned r; asm volatile("v_cvt_pk_bf16_f32 %0, %1, %2" : "=v"(r) : "v"(lo), "v"(hi)); return r; }

struct EpiBf16P {
    static constexpr bool PERM = true, AFTER_DRAIN = false;
    bf16_t* O; int ldc;
    __device__ __forceinline__ void operator()(const f32x4 (&acc)[2][2][4][2], const Unit& u, int, int, int, int) const {
        int t_ = threadIdx.x; asm volatile("" : "+v"(t_)); const int wid_ = __builtin_amdgcn_readfirstlane(t_ >> 6), wr = wid_ >> 2, wc = wid_ & 3, fr = t_ & 15, fq = (t_ >> 4) & 3;
        const int row0 = u.pm * BM + wr * 64 + fr; const int col0 = u.pn * BM + wc * 32 + 8 * fq;
#pragma unroll
        for (int ai = 0; ai < 2; ++ai)
#pragma unroll
            for (int m = 0; m < 4; ++m) { bf16_t* rowp = O + (size_t)(row0 + ai * HALF + m * 16) * ldc + col0;
#pragma unroll
                for (int bj = 0; bj < 2; ++bj) { const f32x4 v0 = acc[ai][bj][m][0], v1 = acc[ai][bj][m][1];
                    u32x4 w; w.x = cvt_pk_bf16(v0[0], v0[1]); w.y = cvt_pk_bf16(v0[2], v0[3]); w.z = cvt_pk_bf16(v1[0], v1[1]); w.w = cvt_pk_bf16(v1[2], v1[3]);
                    *(u32x4*)(rowp + bj * HALF) = w; } }
    }
};
struct EpiF32 {
    static constexpr bool PERM = false, AFTER_DRAIN = false;
    float* O; const float* R; int ldc;
    __device__ __forceinline__ void operator()(const f32x4 (&acc)[2][2][4][2], const Unit& u, int, int, int, int) const {
        int t_ = threadIdx.x; asm volatile("" : "+v"(t_)); const int wid_ = __builtin_amdgcn_readfirstlane(t_ >> 6), wr = wid_ >> 2, wc = wid_ & 3, fr = t_ & 15, fq = (t_ >> 4) & 3;
        const int row0 = u.pm * BM + wr * 64 + fr; const int col0 = u.pn * BM + wc * 32 + 4 * fq;
#pragma unroll
        for (int ai = 0; ai < 2; ++ai)
#pragma unroll
            for (int m = 0; m < 4; ++m) { const size_t off = (size_t)(row0 + ai * HALF + m * 16) * ldc + col0;
#pragma unroll
                for (int bj = 0; bj < 2; ++bj)
#pragma unroll
                    for (int n = 0; n < 2; ++n) { f32x4 v = acc[ai][bj][m][n]; const size_t o = off + bj * HALF + n * 16;
                        if (R) v = v + *(const f32x4*)(R + o);
                        *(f32x4*)(O + o) = v; } }
    }
};

template <class Epi, class Sched, bool ALIGN_EPI = false>
__device__ __forceinline__ void gemm_phase(PG8_LAS unsigned char* lds, const Gemm g, const Sched& S, const Epi& E) {
    int tid_ = threadIdx.x; asm volatile("" : "+v"(tid_));
    const int tid = tid_, wid = __builtin_amdgcn_readfirstlane(tid >> 6), lane = tid & 63, wr = wid >> 2, wc = wid & 3, fr = lane & 15, fq = lane >> 4;
    const int K = g.K, nt = K / BK;
    unsigned voffA[2], voffB[2];
#pragma unroll
    for (int i = 0; i < 2; ++i) { int R, C; stage_rc(tid * 16 + i * 8192, R, C); const int Rb = Epi::PERM ? ((R & ~31) + perm32(R & 31)) : R;
        voffA[i] = (unsigned)(R * g.lda + C) * 2u; voffB[i] = (unsigned)(Rb * g.ldb + C) * 2u; }
    const size_t kstep = (size_t)(BK * 2);
    const size_t hstepA = (size_t)HALF * g.lda * 2, hstepB = (size_t)HALF * g.ldb * 2;
    const size_t tstepA = 2 * hstepA, tstepB = 2 * hstepB;
    const unsigned ldsw = (unsigned)wid * 1024u;
    const int aoff = lds_byte(wr * 64 + fr, fq * 8), boff = lds_byte(wc * 32 + fr, fq * 8);
#define PG8_SA(b, h) (((b) * 2 + (h)) * HTB)
#define PG8_SB(b, h) ((4 + (b) * 2 + (h)) * HTB)
#define PG8_STAGE(bufoff, gbase, voff) do { _Pragma("unroll") for (int _i = 0; _i < 2; ++_i) \
        __builtin_amdgcn_global_load_lds((const unsigned*)((const char*)(gbase) + (voff)[_i]), (PG8_LAS unsigned*)(lds + (bufoff) + ldsw + _i * 8192), 16, 0, 0); } while (0)
#define PG8_LDA(dst, b, h) do { _Pragma("unroll") for (int m = 0; m < 4; ++m) _Pragma("unroll") for (int k = 0; k < 2; ++k) dst[m][k] = *(const PG8_LAS bf16x8*)(lds + PG8_SA(b, h) + aoff + m * 2048 + k * 1024); } while (0)
#define PG8_LDB(dst, b, h) do { _Pragma("unroll") for (int n = 0; n < 2; ++n) _Pragma("unroll") for (int k = 0; k < 2; ++k) dst[n][k] = *(const PG8_LAS bf16x8*)(lds + PG8_SB(b, h) + boff + n * 2048 + k * 1024); } while (0)
#define PG8_MMA(ai, bj, At, Bt) do { __builtin_amdgcn_s_setprio(1); _Pragma("unroll") for (int m = 0; m < 4; ++m) _Pragma("unroll") for (int n = 0; n < 2; ++n) _Pragma("unroll") for (int k = 0; k < 2; ++k) \
        acc[ai][bj][m][n] = __builtin_amdgcn_mfma_f32_16x16x32_bf16(Bt[n][k], At[m][k], acc[ai][bj][m][n], 0, 0, 0); __builtin_amdgcn_s_setprio(0); } while (0)
#define PG8_WAIT_V(n) asm volatile("s_waitcnt vmcnt(" #n ")" ::: "memory")
#define PG8_WAIT_L(n) asm volatile("s_waitcnt lgkmcnt(" #n ")" ::: "memory")
#define PG8_BAR __builtin_amdgcn_s_barrier()
#define PG8_SCHED __builtin_amdgcn_sched_barrier(0)
    Unit cur, nxt; int ui = 0;
    if (!S.next(0, cur)) return;
    f32x4 acc[2][2][4][2];
#pragma unroll
    for (int a = 0; a < 2; ++a)
#pragma unroll
        for (int b = 0; b < 2; ++b)
#pragma unroll
            for (int m = 0; m < 4; ++m)
#pragma unroll
                for (int n = 0; n < 2; ++n) acc[a][b][m][n] = (f32x4){0.f, 0.f, 0.f, 0.f};
    bf16x8 At[4][2], B0[2][2], B1[2][2];
    const char* cA = (const char*)g.A + (size_t)cur.pm * tstepA; const char* cB = (const char*)g.Bt + (size_t)cur.pn * tstepB;
    S.a_ready(cur);
    PG8_STAGE(PG8_SB(0, 0), cB, voffB); PG8_STAGE(PG8_SB(0, 1), cB + hstepB, voffB); PG8_STAGE(PG8_SA(0, 0), cA, voffA); PG8_STAGE(PG8_SA(0, 1), cA + hstepA, voffA);
    if (wr == 1) PG8_BAR;
    PG8_WAIT_V(2); PG8_BAR;
    PG8_STAGE(PG8_SB(1, 0), cB + kstep, voffB); PG8_STAGE(PG8_SA(1, 0), cA + kstep, voffA); PG8_STAGE(PG8_SB(1, 1), cB + hstepB + kstep, voffB);
    PG8_WAIT_V(6); PG8_BAR;
    for (;;) {
        const bool has_next = S.next(ui + 1, nxt);
        const char* nA = has_next ? (const char*)g.A + (size_t)nxt.pm * tstepA : cA; const char* nB = has_next ? (const char*)g.Bt + (size_t)nxt.pn * tstepB : cB;
        for (int t = 0; t < nt; t += 2) {
            const bool last = (t == nt - 2);
            const char* a1 = cA + (size_t)(t + 1) * kstep;
            const char* a2 = last ? nA : cA + (size_t)(t + 2) * kstep; const char* b2 = last ? nB : cB + (size_t)(t + 2) * kstep;
            const char* a3 = a2 + kstep; const char* b3 = b2 + kstep;
            if (last && has_next) S.a_ready(nxt);
            PG8_LDB(B0, 0, 0); PG8_LDB(B1, 0, 1); PG8_SCHED; PG8_LDA(At, 0, 0); PG8_STAGE(PG8_SA(1, 1), a1 + hstepA, voffA);
            PG8_WAIT_V(8); PG8_WAIT_L(0); PG8_BAR; PG8_MMA(0, 0, At, B0); PG8_MMA(0, 1, At, B1); PG8_BAR; PG8_SCHED;
            PG8_LDA(At, 0, 1); PG8_STAGE(PG8_SB(0, 0), b2, voffB); PG8_STAGE(PG8_SB(0, 1), b2 + hstepB, voffB); PG8_STAGE(PG8_SA(0, 0), a2, voffA);
            PG8_WAIT_V(8); PG8_WAIT_L(0); PG8_BAR; PG8_MMA(1, 0, At, B0); PG8_MMA(1, 1, At, B1); PG8_BAR; PG8_SCHED;
            PG8_LDB(B0, 1, 0); PG8_LDB(B1, 1, 1); PG8_SCHED; PG8_LDA(At, 1, 0); PG8_STAGE(PG8_SA(0, 1), a2 + hstepA, voffA);
            PG8_WAIT_V(8); PG8_WAIT_L(0); PG8_BAR; PG8_MMA(0, 0, At, B0); PG8_MMA(0, 1, At, B1); PG8_BAR; PG8_SCHED;
            PG8_LDA(At, 1, 1); PG8_STAGE(PG8_SB(1, 0), b3, voffB); PG8_STAGE(PG8_SB(1, 1), b3 + hstepB, voffB); PG8_STAGE(PG8_SA(1, 0), a3, voffA);
            PG8_WAIT_V(8); PG8_WAIT_L(0); PG8_BAR; PG8_MMA(1, 0, At, B0); PG8_MMA(1, 1, At, B1); PG8_BAR; PG8_SCHED;
        }
        if constexpr (ALIGN_EPI) { if (wr == 0) PG8_BAR; }
        E(acc, cur, wr, wc, fr, fq); S.done(cur);
        if (!has_next) break;
#pragma unroll
        for (int a = 0; a < 2; ++a)
#pragma unroll
            for (int b = 0; b < 2; ++b)
#pragma unroll
                for (int m = 0; m < 4; ++m)
#pragma unroll
                    for (int n = 0; n < 2; ++n) acc[a][b][m][n] = (f32x4){0.f, 0.f, 0.f, 0.f};
        cur = nxt; cA = nA; cB = nB; ++ui;
        if constexpr (ALIGN_EPI) { if (wr == 1) PG8_BAR; }
    }
    PG8_WAIT_V(0);
    if constexpr (!ALIGN_EPI) { if (wr == 0) PG8_BAR; }
    PG8_BAR;
#undef PG8_SA
#undef PG8_SB
#undef PG8_STAGE
#undef PG8_LDA
#undef PG8_LDB
#undef PG8_MMA
#undef PG8_WAIT_V
#undef PG8_WAIT_L
#undef PG8_BAR
#undef PG8_SCHED
}
}
constexpr int NWAVES = 8, NTHREADS = 512;
constexpr int BATCH = 2, SEQ = 4096, DM = 4096, NTOK = BATCH * SEQ;
constexpr int MEM_LEN = 256, NMEM = BATCH * MEM_LEN;
constexpr int XW = 1024, XH = 4, XHD = 256, MIXW = 3072;
constexpr int A_IN = 10240, A_OUTW = 1024, A_CAT = 2048;
constexpr int B_SHIFT = 10048, B_IN = 11072, B_IN_PAD = 11264;
constexpr int LDP = 11264;
constexpr int DFF = 14336, DFF2 = 28672;
constexpr int RH = 48, RHD = 64;
constexpr float NORM_EPS = 1e-6f, GN_EPS = 64e-5f;
constexpr int PB_R = 0, PB_K = 3072, PB_V = 6144, PB_WD = 9216, PB_AD = 9344, PB_VD = 9472, PB_GD = 9568, PB_CQ = 10048;
constexpr int PA_Q = 0, PA_K = 3072, PA_V = 6144, PA_CQ = 9216;

constexpr size_t MiB = 1u << 20;
constexpr size_t WS_CTL = 0, CTL_ZERO_BYTES = 65536;
constexpr size_t WS_ROPE = 1 * MiB;
constexpr size_t WS_WKV = 2 * MiB;
constexpr size_t WS_WAIN = 18 * MiB;
constexpr size_t WS_WAOUT = 98 * MiB;
constexpr size_t WS_WBIN = 114 * MiB;
constexpr size_t WS_WLW = 202 * MiB;
constexpr size_t WS_WLA = WS_WLW + 3 * MiB / 2;
constexpr size_t WS_WLV = WS_WLA + 3 * MiB / 2;
constexpr size_t WS_WLG = WS_WLV + 3 * MiB / 2;
constexpr size_t WS_WBOUT = 210 * MiB;
constexpr size_t WS_WUP = 242 * MiB;
constexpr size_t WS_WDOWN = 690 * MiB;
constexpr size_t WS_X = 914 * MiB;
constexpr size_t WS_H = 1042 * MiB;
constexpr size_t WS_MEMN = 1106 * MiB;
constexpr size_t WS_MEMKV = 1110 * MiB;
constexpr size_t WS_P = 1112 * MiB;
constexpr size_t WS_VFIRST = 1288 * MiB;
constexpr size_t WS_CAT = 1336 * MiB;
constexpr size_t WS_ACT = 1400 * MiB;
constexpr size_t WS_GU = 1624 * MiB;
constexpr size_t WS_HALO = 1624 * MiB, WS_RAWG = 1640 * MiB, WS_RAWU = 1656 * MiB;
constexpr size_t WS_CH = 1680 * MiB;
constexpr size_t WS_SR = 2072 * MiB;
constexpr size_t WS_SW = WS_SR + 96 * MiB, WS_SK = WS_SR + 192 * MiB, WS_SV = WS_SR + 288 * MiB, WS_SA = WS_SR + 384 * MiB, WS_SB = WS_SR + 480 * MiB;
constexpr size_t WS_G = 2648 * MiB;
constexpr size_t WS_Y = 2744 * MiB;
constexpr size_t WS_VT = 2840 * MiB;
constexpr size_t WS_OG = 2840 * MiB;
constexpr size_t WS_LSE = 2936 * MiB;
constexpr size_t WS_LA = 2937 * MiB;
constexpr size_t WS_MEMVT = 2953 * MiB;
constexpr size_t WS_END = 2954 * MiB;
constexpr int CW_TMO = 0, CW_CODE = 1, CW_BAR = 4096;

constexpr int RING_OFF = 0, RING_BYTES = 131072;
constexpr int LDSCTL_OFF = RING_BYTES, MISC_OFF = LDSCTL_OFF + 320;
constexpr int LDS_BYTES = 147456;

#define GAS __attribute__((address_space(1)))
#define LAS __attribute__((address_space(3)))
typedef unsigned short bf16;
typedef unsigned v4u __attribute__((ext_vector_type(4)));
typedef unsigned v2u __attribute__((ext_vector_type(2)));
typedef float f32x4 __attribute__((ext_vector_type(4)));
typedef float f32x2 __attribute__((ext_vector_type(2)));
typedef GAS unsigned gu32;
#define RLX_AGENT __ATOMIC_RELAXED, __HIP_MEMORY_SCOPE_AGENT
#define LDS_WAIT() asm volatile("s_waitcnt lgkmcnt(0)" ::: "memory")
#define VM_WAIT() asm volatile("s_waitcnt vmcnt(0)" ::: "memory")
__device__ __forceinline__ unsigned f2bf(float f) { unsigned u = __builtin_bit_cast(unsigned, f); return (u + 0x7fffu + ((u >> 16) & 1u)) >> 16; }
__device__ __forceinline__ unsigned pk2(float lo, float hi) { return f2bf(lo) | (f2bf(hi) << 16); }
__device__ __forceinline__ float bf2f(unsigned short h) { return __builtin_bit_cast(float, (unsigned)h << 16); }
__device__ __forceinline__ float bflo(unsigned w) { return __builtin_bit_cast(float, w << 16); }
__device__ __forceinline__ float bfhi(unsigned w) { return __builtin_bit_cast(float, w & 0xffff0000u); }
__device__ __forceinline__ float sigmoidf_(float x) { return 1.f / (1.f + __expf(-x)); }

#define XB_TMO      128
#define XB_XCNT(j)  (256  + 64 * (j))
#define XB_XSUB(j)  (1280 + 64 * (j))
#define XB_XGEN(j)  (2304 + 64 * (j))
#define XB_TOP      3328
#define XB_TOPGEN   3392
#define XCD_BAR_WORDS 3456
#define XB_SPIN_CAP (1u << 22)

__device__ __forceinline__ unsigned xb_ld(unsigned* p)              { return __hip_atomic_load(p, __ATOMIC_RELAXED, __HIP_MEMORY_SCOPE_AGENT); }
__device__ __forceinline__ unsigned xb_add(unsigned* p, unsigned v) { return __hip_atomic_fetch_add(p, v, __ATOMIC_RELAXED, __HIP_MEMORY_SCOPE_AGENT); }
__device__ __forceinline__ unsigned xb_xcc_id() { return (unsigned)__builtin_amdgcn_s_getreg((3 << 11) | 20) & 0xFu; }
#define XB_SPIN(cond, bar) do { unsigned _sp = 0; while (cond) { __builtin_amdgcn_s_sleep(1); \
    if ((++_sp & 255u) == 0u) { if (xb_ld(&(bar)[XB_TMO])) break; if (_sp > XB_SPIN_CAP) { atomicAdd(&(bar)[XB_TMO], 1u); break; } } } } while (0)

struct XcdBarrier {
    unsigned* bar; unsigned x;
    volatile LAS unsigned* st;
};
__device__ __forceinline__ XcdBarrier xcd_barrier_post(unsigned* bar, volatile LAS unsigned* st) {
    XcdBarrier b; b.bar = bar; b.x = xb_xcc_id(); b.st = st;
    if (threadIdx.x == 0) (void)xb_add(&bar[XB_XCNT(b.x)], 1u);
    return b;
}
__device__ __forceinline__ void xcd_barrier_complete(unsigned* bar, unsigned x, unsigned& nloc, unsigned& nx) {
    const unsigned G = gridDim.x * gridDim.y * gridDim.z;
    unsigned sum, cnt, mine, sp = 0u;
    for (;;) {
        sum = 0u; cnt = 0u; mine = 0u;
#pragma unroll
        for (unsigned j = 0; j < 16; ++j) { const unsigned c = xb_ld(&bar[XB_XCNT(j)]); sum += c; cnt += (c > 0u) ? 1u : 0u; mine = (j == x) ? c : mine; }
        if (sum == G) break;
        __builtin_amdgcn_s_sleep(1);
        if ((++sp & 255u) == 0u) { if (xb_ld(&bar[XB_TMO])) break; if (sp > XB_SPIN_CAP) { atomicAdd(&bar[XB_TMO], 1u); break; } }
    }
    nloc = mine > 0u ? mine : 1u; nx = cnt > 0u ? cnt : 1u;
}
__device__ __forceinline__ void xcd_barrier(const XcdBarrier& b) {
    asm volatile("s_waitcnt vmcnt(0)" ::: "memory");
    __syncthreads();
    if (threadIdx.x == 0) {
        unsigned* bar = b.bar;
        __builtin_amdgcn_s_waitcnt(0);
        unsigned nloc = b.st[0], nx = b.st[1];
        if (nloc == 0u) { xcd_barrier_complete(bar, b.x, nloc, nx); b.st[0] = nloc; b.st[1] = nx; }
        const unsigned old = xb_add(&bar[XB_XSUB(b.x)], 1u);
        const unsigned gen = old / nloc;
        if (old + 1u == (gen + 1u) * nloc) {
            __builtin_amdgcn_fence(__ATOMIC_RELEASE, "agent");
            asm volatile("s_waitcnt vmcnt(0)" ::: "memory");
            const unsigned og = xb_add(&bar[XB_TOP], 1u);
            const unsigned tg = og / nx;
            if (og + 1u == (tg + 1u) * nx) xb_add(&bar[XB_TOPGEN], 1u);
            else XB_SPIN(xb_ld(&bar[XB_TOPGEN]) == tg, bar);
            __builtin_amdgcn_fence(__ATOMIC_ACQUIRE, "agent");
            xb_add(&bar[XB_XGEN(b.x)], 1u);
            asm volatile("s_waitcnt vmcnt(0)" ::: "memory");
        } else {
            XB_SPIN(xb_ld(&bar[XB_XGEN(b.x)]) == gen, bar);
            __builtin_amdgcn_fence(__ATOMIC_ACQUIRE, "agent");
            asm volatile("s_waitcnt vmcnt(0)" ::: "memory");
        }
    }
    __syncthreads();
}

template <int CTRL> __device__ __forceinline__ float dppf(float x) { return __builtin_bit_cast(float, __builtin_amdgcn_update_dpp(0, __builtin_bit_cast(int, x), CTRL, 0xf, 0xf, true)); }
__device__ __forceinline__ float row16_sum(float x) { x += dppf<0xB1>(x); x += dppf<0x4E>(x); x += dppf<0x141>(x); x += dppf<0x140>(x); return x; }

__device__ __forceinline__ float wave_sum_dpp(float x) {
    x = row16_sum(x);
    x += __builtin_bit_cast(float, __builtin_amdgcn_update_dpp(0, __builtin_bit_cast(int, x), 0x142, 0xa, 0xf, false));
    x += __builtin_bit_cast(float, __builtin_amdgcn_update_dpp(0, __builtin_bit_cast(int, x), 0x143, 0xc, 0xf, false));
    return __builtin_bit_cast(float, __builtin_amdgcn_readlane(__builtin_bit_cast(int, x), 63));
}
__device__ __forceinline__ float wave_sum(float v) { return wave_sum_dpp(v); }
struct Ctx { int tid, lane, wave, gw, NGW, gtid, GT; LAS unsigned char* lds; };

__device__ __forceinline__ void convert_job(const Ctx& C, const float* W, int K, int N, bf16* WT, int ldk, int koff, int Kpad, int mode) {
    LAS float* scr = (LAS float*)(C.lds + RING_OFF + C.wave * 16384);
    const int nblk = N / 32, nitems = (Kpad / 64) * nblk, lane = C.lane;
    for (int item = C.gw; item < nitems; item += C.NGW) {
        const int kb = item / nblk, nb = item % nblk, k0 = 64 * kb, n0 = 32 * nb;
#pragma unroll 8
        for (int i = 0; i < 32; ++i) { const int kk = 2 * i + (lane >> 5); const int ks = k0 + kk - koff;
            float v = 0.f; if (ks >= 0 && ks < K) v = W[(size_t)ks * N + n0 + (lane & 31)];
            scr[kk * 33 + (lane & 31)] = v; }
        LDS_WAIT(); asm volatile("" ::: "memory");
        const int c = lane & 7;
        int d0 = n0;
        if (mode == 1) { d0 = (n0 < DFF) ? (256 * (n0 / 128) + (n0 % 128)) : (256 * ((n0 - DFF) / 128) + 128 + ((n0 - DFF) % 128)); }
#pragma unroll
        for (int j = 0; j < 4; ++j) { const int n = (lane >> 3) + 8 * j; const LAS float* s = scr + (8 * c) * 33 + n;
            v4u o; o.x = pk2(s[0 * 33], s[1 * 33]); o.y = pk2(s[2 * 33], s[3 * 33]); o.z = pk2(s[4 * 33], s[5 * 33]); o.w = pk2(s[6 * 33], s[7 * 33]);
            *(v4u*)(WT + (size_t)(d0 + n) * ldk + k0 + 8 * c) = o; }
        LDS_WAIT(); asm volatile("" ::: "memory");
    }
}

template <bool OUT_F32>
__device__ __forceinline__ void rmsnorm_rows_b(const Ctx& C, const bf16* X, const float* g, void* out, int nrows) {
    for (int row = C.gw; row < nrows; row += C.NGW) {
        const v4u* xr = (const v4u*)(X + (size_t)row * DM) + C.lane;
        float v[8][8]; float s = 0.f;
#pragma unroll
        for (int j = 0; j < 8; ++j) { const v4u w = xr[64 * j];
#pragma unroll
            for (int e = 0; e < 4; ++e) { v[j][2 * e] = bflo(w[e]); v[j][2 * e + 1] = bfhi(w[e]); s += v[j][2 * e] * v[j][2 * e] + v[j][2 * e + 1] * v[j][2 * e + 1]; } }
        const float rstd = 1.f / sqrtf(wave_sum(s) * (1.f / DM) + NORM_EPS);
#pragma unroll
        for (int j = 0; j < 8; ++j) { const int c0 = 8 * (C.lane + 64 * j); const f32x4 g0 = *(const f32x4*)(g + c0), g1 = *(const f32x4*)(g + c0 + 4);
            float y[8];
#pragma unroll
            for (int e = 0; e < 4; ++e) { y[e] = v[j][e] * rstd * g0[e]; y[4 + e] = v[j][4 + e] * rstd * g1[e]; }
            if (OUT_F32) { float* op = (float*)out + (size_t)row * DM + c0; *(f32x4*)op = (f32x4){y[0], y[1], y[2], y[3]}; *(f32x4*)(op + 4) = (f32x4){y[4], y[5], y[6], y[7]}; }
            else { v4u w; w.x = pk2(y[0], y[1]); w.y = pk2(y[2], y[3]); w.z = pk2(y[4], y[5]); w.w = pk2(y[6], y[7]); *(v4u*)((bf16*)out + (size_t)row * DM + c0) = w; } }
    }
}
template <bool OUT_F32>
__device__ __forceinline__ void rmsnorm_rows(const Ctx& C, const float* X, const float* g, void* out, int nrows) {
    for (int row = C.gw; row < nrows; row += C.NGW) {
        const f32x4* xr = (const f32x4*)(X + (size_t)row * DM) + C.lane;
        f32x4 v[16]; float s = 0.f;
#pragma unroll
        for (int j = 0; j < 16; ++j) { v[j] = xr[64 * j]; s += (v[j].x * v[j].x + v[j].y * v[j].y) + (v[j].z * v[j].z + v[j].w * v[j].w); }
        const float rstd = 1.f / sqrtf(wave_sum(s) * (1.f / DM) + NORM_EPS);
        const f32x4* gr = (const f32x4*)g + C.lane;
#pragma unroll
        for (int j = 0; j < 16; ++j) { const f32x4 gg = gr[64 * j]; const f32x4 y = v[j] * rstd * gg;
            if (OUT_F32) ((f32x4*)((float*)out + (size_t)row * DM) + C.lane)[64 * j] = y;
            else { v2u w; w.x = pk2(y.x, y.y); w.y = pk2(y.z, y.w); ((v2u*)((bf16*)out + (size_t)row * DM) + C.lane)[64 * j] = w; } }
    }
}

__device__ __forceinline__ void rope_table(const Ctx& C, const int* pos, float* T) {
    for (int idx = C.gtid; idx < NTOK * 16; idx += C.GT) { const int row = idx >> 4, i = idx & 15;
        const float inv = powf(500000.0f, -(float)i / 16.0f); const float ang = (float)pos[row] * inv;
        T[2 * idx] = cosf(ang); T[2 * idx + 1] = sinf(ang); }
}


__device__ __forceinline__ float shiftv(const bf16* P, int row, int t, int c, const float* mu) {
    const float cur = bf2f(P[(size_t)row * LDP + c]); const float prev = (t > 0) ? bf2f(P[(size_t)(row - 1) * LDP + c]) : 0.f;
    return cur + (prev - cur) * mu[c];
}
__device__ __forceinline__ void prep_b1(const Ctx& C, const bf16* P, const float* mu, bf16* LA) {
    for (int idx = C.gtid; idx < NTOK * 128; idx += C.GT) { const int row = idx >> 7, c = (idx & 127) * 8, t = row & (SEQ - 1);
        int src = -1, mode = 0;
        if (c < 128) { src = PB_WD + c; mode = 1; } else if (c < 256) { src = PB_AD + (c - 128); mode = 2; } else if (c < 352) { src = PB_VD + (c - 256); mode = 2; }
        else if (c >= 512 && c < 992) { src = PB_GD + (c - 512); mode = 3; }
        v4u o = (v4u){0u, 0u, 0u, 0u};
        if (src >= 0) { const v4u cw = *(const v4u*)(P + (size_t)row * LDP + src); v4u pw = (v4u){0u, 0u, 0u, 0u}; if (t > 0) pw = *(const v4u*)(P + (size_t)(row - 1) * LDP + src);
            const f32x4 m0 = *(const f32x4*)(mu + src), m1 = *(const f32x4*)(mu + src + 4);
            float r[8];
#pragma unroll
            for (int e = 0; e < 8; ++e) { const float cur = (e & 1) ? bfhi(cw[e >> 1]) : bflo(cw[e >> 1]), prv = (e & 1) ? bfhi(pw[e >> 1]) : bflo(pw[e >> 1]), mm = (e < 4) ? m0[e & 3] : m1[e & 3];
                const float x = cur + (prv - cur) * mm; r[e] = (mode == 1) ? tanhf(x) : ((mode == 3) ? sigmoidf_(x) : x); }
            o.x = pk2(r[0], r[1]); o.y = pk2(r[2], r[3]); o.z = pk2(r[4], r[5]); o.w = pk2(r[6], r[7]); }
        *(v4u*)(LA + (size_t)row * 1024 + c) = o; }
}

typedef short bf16x8v __attribute__((ext_vector_type(8)));
typedef short bf16x4v __attribute__((ext_vector_type(4)));


__device__ __forceinline__ float SFMA(float a, float b, float c) { float d; asm("v_fma_f32 %0, %1, %2, %3" : "=v"(d) : "v"(a), "v"(b), "v"(c)); return d; }
__device__ __forceinline__ float SMUL(float a, float b) { float d; asm("v_mul_f32 %0, %1, %2" : "=v"(d) : "v"(a), "v"(b)); return d; }
constexpr int SC_T = 32, SC_N = SC_T * 64, SC_BUF = 6 * SC_N;

namespace pg8 {
template <int MODE> struct EpiLora {
    static constexpr bool PERM = true, AFTER_DRAIN = false;
    bf16_t* O; const float* bias; const bf16_t* P; const float* mu; const bf16_t* VF; bf16_t* O2; const float* bias2;
    __device__ __forceinline__ void operator()(const f32x4 (&acc)[2][2][4][2], const Unit& u, int, int, int, int) const {
        int t_ = threadIdx.x; asm volatile("" : "+v"(t_)); const int wid_ = __builtin_amdgcn_readfirstlane(t_ >> 6), wr = wid_ >> 2, wc = wid_ & 3, fr = t_ & 15, fq = (t_ >> 4) & 3;
        if constexpr (MODE == 2) {
            const int row0 = u.pm * BM + wr * 64 + fr; const int colt = u.pn * BM + wc * 32 + 8 * fq;
#pragma unroll
            for (int bj = 0; bj < 2; ++bj) { const int c = colt + bj * HALF;
                const f32x4 b0 = *(const f32x4*)(bias + c), b1 = *(const f32x4*)(bias + c + 4), m0 = *(const f32x4*)(mu + PB_V + c), m1 = *(const f32x4*)(mu + PB_V + c + 4);
#pragma unroll
                for (int ai = 0; ai < 2; ++ai)
#pragma unroll
                    for (int m = 0; m < 4; ++m) { const int row = row0 + ai * HALF + m * 16; const int t = row & (SEQ - 1);
                        const u32x4 cw = *(const u32x4*)(P + (size_t)row * LDP + PB_V + c); u32x4 pw = (u32x4){0u, 0u, 0u, 0u}; if (t > 0) pw = *(const u32x4*)(P + (size_t)(row - 1) * LDP + PB_V + c);
                        const u32x4 fw = *(const u32x4*)(VF + (size_t)row * MIXW + c);
                        f32x4 v0 = acc[ai][bj][m][0], v1 = acc[ai][bj][m][1];
#pragma unroll
                        for (int e = 0; e < 4; ++e) {
                            { const unsigned cwe = cw[e >> 1], pwe = pw[e >> 1], fwe = fw[e >> 1]; const float cur = (e & 1) ? bfhi(cwe) : bflo(cwe), prv = (e & 1) ? bfhi(pwe) : bflo(pwe), vf = (e & 1) ? bfhi(fwe) : bflo(fwe);
                              const float gt = __builtin_amdgcn_rcpf(1.f + __expf(-(b0[e] + v0[e]))); const float vs = cur + (prv - cur) * m0[e]; v0[e] = vs + (vf - vs) * gt; }
                            { const unsigned cwe = cw[2 + (e >> 1)], pwe = pw[2 + (e >> 1)], fwe = fw[2 + (e >> 1)]; const float cur = (e & 1) ? bfhi(cwe) : bflo(cwe), prv = (e & 1) ? bfhi(pwe) : bflo(pwe), vf = (e & 1) ? bfhi(fwe) : bflo(fwe);
                              const float gt = __builtin_amdgcn_rcpf(1.f + __expf(-(b1[e] + v1[e]))); const float vs = cur + (prv - cur) * m1[e]; v1[e] = vs + (vf - vs) * gt; } }
                        u32x4 w_; w_.x = cvt_pk_bf16(v0[0], v0[1]); w_.y = cvt_pk_bf16(v0[2], v0[3]); w_.z = cvt_pk_bf16(v1[0], v1[1]); w_.w = cvt_pk_bf16(v1[2], v1[3]);
                        *(u32x4*)(O + (size_t)row * MIXW + c) = w_; }
                asm volatile("" ::: "memory"); }
        } else {
            const int row0 = u.pm * BM + wr * 64 + fr; const int colt = u.pn * BM + wc * 32 + 8 * fq;
            const bool isw = (MODE == 4) ? (u.pn < 12) : true;
            const float sc_ = (MODE == 0 || (MODE == 4 && isw)) ? -0.6065306597126334f : 1.f;
            const float* bp = (MODE == 4 && !isw) ? bias2 : bias; bf16_t* Op = (MODE == 4 && !isw) ? O2 : O;
#pragma unroll
            for (int bj = 0; bj < 2; ++bj) { const int c = ((MODE == 4 && !isw) ? colt - MIXW : colt) + bj * HALF;
                f32x4 b0 = (f32x4){0.f, 0.f, 0.f, 0.f}, b1 = b0;
                if (MODE != 3) { b0 = *(const f32x4*)(bp + c); b1 = *(const f32x4*)(bp + c + 4); }
#pragma unroll
                for (int ai = 0; ai < 2; ++ai)
#pragma unroll
                    for (int m = 0; m < 4; ++m) { const int row = row0 + ai * HALF + m * 16;
                        f32x4 v0 = acc[ai][bj][m][0], v1 = acc[ai][bj][m][1];
                        if (MODE != 3) {
#pragma unroll
                            for (int e = 0; e < 4; ++e) { v0[e] = sc_ * __builtin_amdgcn_rcpf(1.f + __expf(-(b0[e] + v0[e]))); v1[e] = sc_ * __builtin_amdgcn_rcpf(1.f + __expf(-(b1[e] + v1[e]))); } }
                        u32x4 w_; w_.x = cvt_pk_bf16(v0[0], v0[1]); w_.y = cvt_pk_bf16(v0[2], v0[3]); w_.z = cvt_pk_bf16(v1[0], v1[1]); w_.w = cvt_pk_bf16(v1[2], v1[3]);
                        *(u32x4*)(Op + (size_t)row * MIXW + c) = w_; }
                asm volatile("" ::: "memory"); }
        }
    }
};
template <bool R_F32> struct EpiResB {
    static constexpr bool PERM = true, AFTER_DRAIN = false;
    bf16_t* XO; const void* R;
    __device__ __forceinline__ void operator()(const f32x4 (&acc)[2][2][4][2], const Unit& u, int, int, int, int) const {
        int t_ = threadIdx.x; asm volatile("" : "+v"(t_)); const int wid_ = __builtin_amdgcn_readfirstlane(t_ >> 6), wr = wid_ >> 2, wc = wid_ & 3, fr = t_ & 15, fq = (t_ >> 4) & 3;
        const int row0 = u.pm * BM + wr * 64 + fr; const int col0 = u.pn * BM + wc * 32 + 8 * fq;
#pragma unroll
        for (int ai = 0; ai < 2; ++ai)
#pragma unroll
            for (int m = 0; m < 4; ++m) { const size_t off = (size_t)(row0 + ai * HALF + m * 16) * DM + col0;
#pragma unroll
                for (int bj = 0; bj < 2; ++bj) { f32x4 v0 = acc[ai][bj][m][0], v1 = acc[ai][bj][m][1];
                    if (R_F32) { const float* rp = (const float*)R + off + bj * HALF; v0 = v0 + *(const f32x4*)rp; v1 = v1 + *(const f32x4*)(rp + 4); }
                    else { const u32x4 rw = *(const u32x4*)((const bf16_t*)R + off + bj * HALF);
                        v0 = v0 + (f32x4){bflo(rw.x), bfhi(rw.x), bflo(rw.y), bfhi(rw.y)}; v1 = v1 + (f32x4){bflo(rw.z), bfhi(rw.z), bflo(rw.w), bfhi(rw.w)}; }
                    u32x4 w; w.x = cvt_pk_bf16(v0[0], v0[1]); w.y = cvt_pk_bf16(v0[2], v0[3]); w.z = cvt_pk_bf16(v1[0], v1[1]); w.w = cvt_pk_bf16(v1[2], v1[3]);
                    *(u32x4*)(XO + off + bj * HALF) = w; }
                if (m & 1) asm volatile("" ::: "memory"); }
    }
};
}

__device__ __forceinline__ void convert_fast(const Ctx& C, const float* W, int K, int N, bf16* WT, int ldk, int mode, int gw0 = -1, int ngw = 0, int it0 = 0, int it1 = 0x7fffffff) {
    if (gw0 < 0) { gw0 = C.gw; ngw = C.NGW; }
    constexpr int PITCH = 144;
    LAS unsigned char* T = C.lds + RING_OFF + C.wave * 16384;
    const int nblk = N / 64, nitems = (K / 64) * nblk, lane = C.lane, nq = lane & 15, kg = lane >> 4;
    const int iend = nitems < it1 ? nitems : it1;
    for (int item = it0 + gw0; item < iend; item += ngw) {
        const int kb = item / nblk, nb = item % nblk, k0 = 64 * kb, n0 = 64 * nb;
        f32x4 v[2][8];
#pragma unroll
        for (int h = 0; h < 2; ++h)
#pragma unroll
            for (int e = 0; e < 8; ++e) v[h][e] = __builtin_nontemporal_load((const f32x4*)(W + (size_t)(k0 + 32 * h + 8 * kg + e) * N + n0 + 4 * nq));
#pragma unroll
        for (int h = 0; h < 2; ++h)
#pragma unroll
            for (int j = 0; j < 4; ++j) { v4u o; o.x = pk2(v[h][0][j], v[h][1][j]); o.y = pk2(v[h][2][j], v[h][3][j]); o.z = pk2(v[h][4][j], v[h][5][j]); o.w = pk2(v[h][6][j], v[h][7][j]);
                *(LAS v4u*)(T + (4 * nq + j) * PITCH + (32 * h + 8 * kg) * 2) = o; }
        LDS_WAIT(); asm volatile("" ::: "memory");
        int d0 = n0;
        if (mode == 1) { d0 = (n0 < DFF) ? (256 * (n0 / 128) + (n0 % 128)) : (256 * ((n0 - DFF) / 128) + 128 + ((n0 - DFF) % 128)); }
#pragma unroll
        for (int s = 0; s < 8; ++s) { const int n = 8 * s + (lane >> 3), kc = lane & 7;
            const v4u o = *(const LAS v4u*)(T + n * PITCH + kc * 16);
            *(v4u*)(WT + (size_t)(d0 + n) * ldk + k0 + 8 * kc) = o; }
        LDS_WAIT(); asm volatile("" ::: "memory");
    }
}

__device__ __forceinline__ void vt_build(const Ctx& C, const bf16* VF, bf16* VT, int gw0, int ngw) {
    constexpr int PITCH = 272;
    LAS unsigned char* T = C.lds + RING_OFF + C.wave * 16384;
    const int lane = C.lane;
    for (int item = gw0; item < BATCH * 24 * 128; item += ngw) {
        const int iblk = item & 127, h = (item >> 7) % 24, b = item / (128 * 24), grp = h >> 3, ld = 2 * grp, d = 1 << ld, Lg = SEQ >> ld;
        const int i0 = iblk * 32, r = i0 / Lg, m0 = i0 % Lg;
#pragma unroll
        for (int s = 0; s < 8; ++s) { const int pi = 4 * s + (lane >> 4); const int pos = (m0 + pi) * d + r;
            const v4u x = *(const v4u*)(VF + (size_t)(b * SEQ + pos) * MIXW + h * 128 + 8 * (lane & 15));
            *(LAS v4u*)(T + pi * PITCH + 16 * (lane & 15)) = x; }
        LDS_WAIT(); asm volatile("" ::: "memory");
#pragma unroll
        for (int s = 0; s < 8; ++s) { const int dim = (s & 1) * 64 + lane, gq = s >> 1;
            unsigned short e[8];
#pragma unroll
            for (int k = 0; k < 8; ++k) e[k] = *(const LAS unsigned short*)(T + (8 * gq + k) * PITCH + dim * 2);
            v4u o; o.x = (unsigned)e[0] | ((unsigned)e[1] << 16); o.y = (unsigned)e[2] | ((unsigned)e[3] << 16); o.z = (unsigned)e[4] | ((unsigned)e[5] << 16); o.w = (unsigned)e[6] | ((unsigned)e[7] << 16);
            *(v4u*)(VT + (size_t)(b * 24 + h) * (128 * SEQ) + (size_t)((iblk * 8 + (dim >> 4)) * 2 + (gq >> 1)) * 256 + (dim & 15) * 16 + (gq & 1) * 8) = o; }
        LDS_WAIT(); asm volatile("" ::: "memory");
    }
}

__device__ __forceinline__ void attn_mfma(const Ctx& C, const bf16* P, const bf16* KB2, const bf16* VT, bf16* CAT) {
    const int lane = C.lane, c = lane & 15, g = lane >> 4;
    const float sc = 0.08838834764831845f * 1.4426950408889634f;
    const int vcu_ = (gridDim.x % 8 == 0) ? (int)((blockIdx.x % 8) * (gridDim.x / 8) + blockIdx.x / 8) : (int)blockIdx.x;
    for (int U = vcu_; U < 512; U += gridDim.x) {
        const int half = U & 1, chunk = (U >> 1) & 15, j = (U >> 5) & 7, b = U >> 8;
        const int r16 = half * 8 + C.wave, base = chunk * 256, qpos = base + 16 * c + r16;
        float m = -1e30f, l = 0.f; f32x4 o[8];
#pragma unroll
        for (int dt = 0; dt < 8; ++dt) o[dt] = (f32x4){0.f, 0.f, 0.f, 0.f};
#pragma unroll
        for (int grp = 0; grp < 3; ++grp) {
            const int ld = 2 * grp, d = 1 << ld, Lg = SEQ >> ld, h = 8 * grp + j, rg = r16 & (d - 1);
            const int mq = qpos >> ld, lo = (mq - 128 > 0) ? (mq - 128) : 0;
            const int m0 = (base + r16) >> ld, m15 = (base + 240 + r16) >> ld;
            const int kstart = (m0 - 128) & ~31, nsteps = ((m15 - kstart) >> 5) + 1;
            bf16x8v qf[4];
            { const bf16* qp = P + (size_t)(b * SEQ + qpos) * LDP + PA_Q + h * 128 + 8 * g;
#pragma unroll
              for (int ks = 0; ks < 4; ++ks) qf[ks] = *(const bf16x8v*)(qp + 32 * ks); }
            const bf16* kbase = KB2 + (size_t)(b * 24 + h) * (128 * SEQ) + (size_t)(rg * (Lg >> 4)) * 2048 + c * 32 + g * 8;
            const bf16* vbase = VT + (size_t)(b * 24 + h) * (128 * SEQ) + (size_t)(rg * (Lg >> 5)) * 4096 + c * 16 + g * 4;
            bf16x8v kc[8], kn[8];
#define ATT_KLOAD(dst, ss) do { int kt_ = (kstart >> 4) + 2 * (ss); kt_ = kt_ < 0 ? 0 : (kt_ > (Lg >> 4) - 2 ? (Lg >> 4) - 2 : kt_);       \
                const bf16* kp_ = kbase + (size_t)kt_ * 2048; \
                _Pragma("unroll") for (int ks = 0; ks < 4; ++ks) { dst[ks] = *(const bf16x8v*)(kp_ + ks * 512); dst[4 + ks] = *(const bf16x8v*)(kp_ + 2048 + ks * 512); } } while (0)
            v2u x0[8], x1[8], y0[8], y1[8];
#define ATT_VLOAD(d0, d1, ss) do { int kbk_ = (kstart >> 5) + (ss); kbk_ = kbk_ < 0 ? 0 : (kbk_ > (Lg >> 5) - 1 ? (Lg >> 5) - 1 : kbk_);       \
                const bf16* vb_ = vbase + (size_t)kbk_ * 4096; \
                _Pragma("unroll") for (int dt = 0; dt < 8; ++dt) { d0[dt] = *(const v2u*)(vb_ + dt * 512); d1[dt] = *(const v2u*)(vb_ + dt * 512 + 256); } } while (0)
            ATT_KLOAD(kc, 0); ATT_VLOAD(x0, x1, 0);
            for (int s = 0; s < nsteps; ++s) {
                const int kb = kstart + 32 * s;
                const int v4a = kb + 4 * g, v4b = kb + 16 + 4 * g;
                ATT_KLOAD(kn, s + 1); ATT_VLOAD(y0, y1, s + 1);
                f32x4 s0 = (f32x4){0.f, 0.f, 0.f, 0.f}, s1 = (f32x4){0.f, 0.f, 0.f, 0.f};
#pragma unroll
                for (int ks = 0; ks < 4; ++ks) { s0 = __builtin_amdgcn_mfma_f32_16x16x32_bf16(kc[ks], qf[ks], s0, 0, 0, 0); s1 = __builtin_amdgcn_mfma_f32_16x16x32_bf16(kc[4 + ks], qf[ks], s1, 0, 0, 0); }
                float t[8]; bool ok[8]; float mx = -1e30f;
#pragma unroll
                for (int r = 0; r < 4; ++r) { const int k0i = v4a + r, k1i = v4b + r; ok[r] = (k0i >= lo) && (k0i <= mq); ok[4 + r] = (k1i >= lo) && (k1i <= mq);
                    t[r] = s0[r] * sc; t[4 + r] = s1[r] * sc; if (ok[r]) mx = fmaxf(mx, t[r]); if (ok[4 + r]) mx = fmaxf(mx, t[4 + r]); }
                mx = fmaxf(mx, __shfl_xor(mx, 16)); mx = fmaxf(mx, __shfl_xor(mx, 32));
                const float mn = fmaxf(m, mx), alpha = __builtin_amdgcn_exp2f(m - mn); m = mn;
                float p[8], ps = 0.f;
#pragma unroll
                for (int r = 0; r < 8; ++r) { p[r] = ok[r] ? __builtin_amdgcn_exp2f(t[r] - mn) : 0.f; ps += p[r]; }
                l = l * alpha + ps;
#pragma unroll
                for (int dt = 0; dt < 8; ++dt) o[dt] = o[dt] * alpha;
                v4u pw; pw.x = pk2(p[0], p[1]); pw.y = pk2(p[2], p[3]); pw.z = pk2(p[4], p[5]); pw.w = pk2(p[6], p[7]);
                const bf16x8v pf = __builtin_bit_cast(bf16x8v, pw);
#pragma unroll
                for (int dt = 0; dt < 8; ++dt) { v4u vw; vw.x = x0[dt].x; vw.y = x0[dt].y; vw.z = x1[dt].x; vw.w = x1[dt].y;
                    o[dt] = __builtin_amdgcn_mfma_f32_16x16x32_bf16(__builtin_bit_cast(bf16x8v, vw), pf, o[dt], 0, 0, 0); }
#pragma unroll
                for (int i = 0; i < 8; ++i) { kc[i] = kn[i]; x0[i] = y0[i]; x1[i] = y1[i]; }
            }
#undef ATT_KLOAD
#undef ATT_VLOAD
        }
        l += __shfl_xor(l, 16); l += __shfl_xor(l, 32);
        const float inv = 1.f / l;
        bf16* op = CAT + (size_t)(b * SEQ + qpos) * A_CAT + j * 128 + 4 * g;
#pragma unroll
        for (int dt = 0; dt < 8; ++dt) { v2u ow; ow.x = pk2(o[dt][0] * inv, o[dt][1] * inv); ow.y = pk2(o[dt][2] * inv, o[dt][3] * inv); *(v2u*)(op + dt * 16) = ow; }
    }
}

namespace pg8 {
struct EpiConvAct {
    static constexpr bool PERM = true, AFTER_DRAIN = false;
    bf16_t* ACT; float* HALO; float* RAWG; float* RAWU; const float* cw; const float* cb;
    __device__ __forceinline__ void operator()(const f32x4 (&acc)[2][2][4][2], const Unit& u, int, int, int, int) const {
        int t_ = threadIdx.x; asm volatile("" : "+v"(t_)); const int wid_ = __builtin_amdgcn_readfirstlane(t_ >> 6), wr = wid_ >> 2, wc = wid_ & 3, fr = t_ & 15, fq = (t_ >> 4) & 3;
        const int c0 = u.pn * HALF + wc * 32 + 8 * fq;
#pragma unroll
        for (int ai = 0; ai < 2; ++ai) {
            const int rb = u.pm * 4 + ai * 2 + wr;
            const int row0 = rb * 64 + fr;
            unsigned pk0[4][2];
#pragma unroll
            for (int n = 0; n < 2; ++n) {
                const f32x4 w0 = *(const f32x4*)(cw + c0 + 4 * n), w1 = *(const f32x4*)(cw + DFF + c0 + 4 * n), w2 = *(const f32x4*)(cw + 2 * DFF + c0 + 4 * n), bb = *(const f32x4*)(cb + c0 + 4 * n);
                float o[4][4];
#pragma unroll
                for (int e = 0; e < 4; ++e) { float g[4], r1[4], r2[4];
#pragma unroll
                    for (int m = 0; m < 4; ++m) { g[m] = acc[ai][0][m][n][e]; r1[m] = dppf<0x121>(g[m]); r2[m] = dppf<0x122>(g[m]); }
#pragma unroll
                    for (int m = 0; m < 4; ++m) { const float p1 = (m > 0 && fr == 0) ? r1[m > 0 ? m - 1 : 0] : r1[m], p2 = (m > 0 && fr < 2) ? r2[m > 0 ? m - 1 : 0] : r2[m];
                        const float gt = bb[e] + w0[e] * p2 + w1[e] * p1 + w2[e] * g[m];
                        o[m][e] = gt * __builtin_amdgcn_rcpf(1.f + __expf(-gt)) * acc[ai][1][m][n][e]; } }
#pragma unroll
                for (int m = 0; m < 4; ++m) { const unsigned wx = cvt_pk_bf16(o[m][0], o[m][1]), wy = cvt_pk_bf16(o[m][2], o[m][3]);
                    if (n == 0) { pk0[m][0] = wx; pk0[m][1] = wy; }
                    else if (m > 0 || fr >= 2) { u32x4 w; w.x = pk0[m][0]; w.y = pk0[m][1]; w.z = wx; w.w = wy; *(u32x4*)(ACT + (size_t)(row0 + 16 * m) * DFF + c0) = w; } }
                asm volatile("" ::: "memory");
            }
            if (fr < 2) { float* pg = RAWG + ((size_t)rb * 2 + fr) * DFF + c0; float* pu = RAWU + ((size_t)rb * 2 + fr) * DFF + c0;
                *(f32x4*)pg = acc[ai][0][0][0]; *(f32x4*)(pg + 4) = acc[ai][0][0][1]; *(f32x4*)pu = acc[ai][1][0][0]; *(f32x4*)(pu + 4) = acc[ai][1][0][1]; }
            if (fr >= 14) { float* ph = HALO + ((size_t)rb * 2 + (fr - 14)) * DFF + c0; *(f32x4*)ph = acc[ai][0][3][0]; *(f32x4*)(ph + 4) = acc[ai][0][3][1]; }
            asm volatile("" ::: "memory");
        }
    }
};
}
__device__ __forceinline__ void convact_fixup(const Ctx& C, const float* HALO, const float* RAWG, const float* RAWU, const float* cw, const float* cb, bf16* ACT) {
    for (int idx = C.gtid; idx < 128 * 2 * (DFF / 4); idx += C.GT) { const int c4 = idx % (DFF / 4), rr = (idx / (DFF / 4)) & 1, rb = idx / (2 * (DFF / 4)), c = 4 * c4;
        const f32x4 g0 = *(const f32x4*)(RAWG + ((size_t)rb * 2 + rr) * DFF + c), uu = *(const f32x4*)(RAWU + ((size_t)rb * 2 + rr) * DFF + c);
        f32x4 gm1 = (f32x4){0.f, 0.f, 0.f, 0.f}, gm2 = (f32x4){0.f, 0.f, 0.f, 0.f};
        const bool has_prev = (rb & 63) != 0;
        if (rr == 0) { if (has_prev) { gm1 = *(const f32x4*)(HALO + ((size_t)(rb - 1) * 2 + 1) * DFF + c); gm2 = *(const f32x4*)(HALO + ((size_t)(rb - 1) * 2 + 0) * DFF + c); } }
        else { gm1 = *(const f32x4*)(RAWG + ((size_t)rb * 2 + 0) * DFF + c); if (has_prev) gm2 = *(const f32x4*)(HALO + ((size_t)(rb - 1) * 2 + 1) * DFF + c); }
        const f32x4 a0 = *(const f32x4*)(cw + c), a1 = *(const f32x4*)(cw + DFF + c), a2 = *(const f32x4*)(cw + 2 * DFF + c), b0 = *(const f32x4*)(cb + c);
        float r[4];
#pragma unroll
        for (int e = 0; e < 4; ++e) { const float gt = b0[e] + a0[e] * gm2[e] + a1[e] * gm1[e] + a2[e] * g0[e]; r[e] = gt * __builtin_amdgcn_rcpf(1.f + __expf(-gt)) * uu[e]; }
        v2u w; w.x = pk2(r[0], r[1]); w.y = pk2(r[2], r[3]);
        *(v2u*)(ACT + (size_t)(rb * 64 + rr) * DFF + c) = w; }
}

constexpr int CH_REC = 15360, CH_G = 12608, CH_AT = 0, CH_RT = 2048, CH_BK = 4096, CH_VT = 8192, CH_NN = 10240, CH_MAK = 11264, CH_TT = 11776, CH_PC = 12288, CH_BON = 12544;
__device__ __forceinline__ void scan_pre(const Ctx& C, const bf16* P, const float* mu, const float* k_k, const float* k_a, const float* r_k,
                                         const bf16* SW, const bf16* SA, const bf16* SV, const bf16* GG, unsigned char* CH) {
    const int lane = C.lane, tl = lane & 15, g = lane >> 4;
    LAS unsigned char* L = C.lds + RING_OFF + C.wave * 16384;
    LAS unsigned short* LAt = (LAS unsigned short*)L; LAS unsigned short* LRt = LAt + 1024; LAS unsigned short* LBt = LAt + 2048; LAS unsigned short* LKt = LAt + 3072;
    LAS float* Mf = (LAS float*)(L + 8192);
    for (int item = C.gw; item < BATCH * RH * 256; item += C.NGW) {
        const int c = item & 255, bh = item >> 8, b = bh / RH, hh = bh % RH, cj = hh * 64 + lane;
        const float mur = mu[PB_R + cj], muk = mu[PB_K + cj], kkj = k_k[cj], kaj = k_a[cj], rkj = r_k[cj];
        unsigned char* rec = CH + (size_t)item * CH_REC;
        float rr[16], k2[16], aa[16], bb[16], ww[16]; unsigned vv[16], gg_[16]; float bon = 0.f;
#pragma unroll
        for (int t = 0; t < 16; ++t) { const int tt = 16 * c + t; const size_t row = (size_t)b * SEQ + tt;
            const bf16* pp = P + row * LDP + cj; const bf16* pq = (tt > 0) ? (pp - LDP) : pp;
            const unsigned pr = pp[PB_R], pk = pp[PB_K], pr1 = pq[PB_R], pk1 = pq[PB_K];
            const size_t o = row * MIXW + cj; const float as = bf2f(SA[o]); ww[t] = bf2f(SW[o]); vv[t] = SV[o]; gg_[t] = GG[o];
            const float rc = bflo(pr), kc = bflo(pk), rp = (tt > 0) ? bflo(pr1) : 0.f, kp = (tt > 0) ? bflo(pk1) : 0.f;
            const float r = rc + (rp - rc) * mur, k = kc + (kp - kc) * muk;
            float kk = k * kkj; const float nrm = sqrtf(wave_sum_dpp(kk * kk)); kk = kk / fmaxf(nrm, 1e-12f);
            rr[t] = r; aa[t] = -kk; bb[t] = kk * as; k2[t] = k * (1.f + (as - 1.f) * kaj);
            const float bt = wave_sum_dpp(r * k2[t] * rkj); if (lane == t) bon = bt; }
        float p = 1.f, cs_ = 0.f, ip[16];
#pragma unroll
        for (int t = 0; t < 16; ++t) { const float pm1 = p; cs_ += ww[t]; p = __expf(cs_); ip[t] = __expf(-cs_);
            LAt[t * 64 + lane] = (unsigned short)f2bf(aa[t] * pm1); LRt[t * 64 + lane] = (unsigned short)f2bf(rr[t] * p);
            LBt[t * 64 + lane] = (unsigned short)f2bf(bb[t] * ip[t]); LKt[t * 64 + lane] = (unsigned short)f2bf(k2[t] * ip[t]); }
#pragma unroll
        for (int gg = 0; gg < 4; ++gg) { v4u o;
            o.x = pk2(bb[4 * gg] * ip[4 * gg] * p, bb[4 * gg + 1] * ip[4 * gg + 1] * p); o.y = pk2(bb[4 * gg + 2] * ip[4 * gg + 2] * p, bb[4 * gg + 3] * ip[4 * gg + 3] * p);
            o.z = pk2(k2[4 * gg] * ip[4 * gg] * p, k2[4 * gg + 1] * ip[4 * gg + 1] * p); o.w = pk2(k2[4 * gg + 2] * ip[4 * gg + 2] * p, k2[4 * gg + 3] * ip[4 * gg + 3] * p);
            *(v4u*)(rec + CH_BK + (lane * 4 + gg) * 16) = o; }
        *(float*)(rec + CH_PC + lane * 4) = p;
#define PKB(a, b) ((a) | ((b) << 16))
        { v4u o0, o1; o0.x = PKB(vv[0], vv[1]); o0.y = PKB(vv[2], vv[3]); o0.z = PKB(vv[4], vv[5]); o0.w = PKB(vv[6], vv[7]); o1.x = PKB(vv[8], vv[9]); o1.y = PKB(vv[10], vv[11]); o1.z = PKB(vv[12], vv[13]); o1.w = PKB(vv[14], vv[15]);
          *(v4u*)(rec + CH_VT + lane * 32) = o0; *(v4u*)(rec + CH_VT + lane * 32 + 16) = o1; }
        { v4u o0, o1; o0.x = PKB(gg_[0], gg_[1]); o0.y = PKB(gg_[2], gg_[3]); o0.z = PKB(gg_[4], gg_[5]); o0.w = PKB(gg_[6], gg_[7]); o1.x = PKB(gg_[8], gg_[9]); o1.y = PKB(gg_[10], gg_[11]); o1.z = PKB(gg_[12], gg_[13]); o1.w = PKB(gg_[14], gg_[15]);
          *(v4u*)(rec + CH_G + lane * 32) = o0; *(v4u*)(rec + CH_G + lane * 32 + 16) = o1; }
        if (lane < 16) *(float*)(rec + CH_BON + lane * 4) = bon;
        LDS_WAIT(); asm volatile("" ::: "memory");
#pragma unroll
        for (int ks = 0; ks < 2; ++ks) { const int j0 = tl * 64 + 32 * ks + 4 * g;
            const v2u a0 = *(const LAS v2u*)(LAt + j0), a1 = *(const LAS v2u*)(LAt + j0 + 16), r0 = *(const LAS v2u*)(LRt + j0), r1 = *(const LAS v2u*)(LRt + j0 + 16);
            v4u oa, orr; oa.x = a0.x; oa.y = a0.y; oa.z = a1.x; oa.w = a1.y; orr.x = r0.x; orr.y = r0.y; orr.z = r1.x; orr.w = r1.y;
            *(v4u*)(rec + CH_AT + tl * 128 + (32 * ks + 8 * g) * 2) = oa; *(v4u*)(rec + CH_RT + tl * 128 + (32 * ks + 8 * g) * 2) = orr; }
        f32x4 mab = (f32x4){0.f, 0.f, 0.f, 0.f}, mak = mab, nbr = mab, nkr = mab;
#pragma unroll
        for (int ks = 0; ks < 2; ++ks) { const int fo = tl * 64 + 32 * ks + 8 * g;
            const bf16x8v fb = *(const LAS bf16x8v*)(LBt + fo), fk = *(const LAS bf16x8v*)(LKt + fo), fa = *(const LAS bf16x8v*)(LAt + fo), fr_ = *(const LAS bf16x8v*)(LRt + fo);
            mab = __builtin_amdgcn_mfma_f32_16x16x32_bf16(fb, fa, mab, 0, 0, 0); mak = __builtin_amdgcn_mfma_f32_16x16x32_bf16(fk, fa, mak, 0, 0, 0);
            nbr = __builtin_amdgcn_mfma_f32_16x16x32_bf16(fb, fr_, nbr, 0, 0, 0); nkr = __builtin_amdgcn_mfma_f32_16x16x32_bf16(fk, fr_, nkr, 0, 0, 0); }
#pragma unroll
        for (int e = 0; e < 4; ++e) { const int s = 4 * g + e; if (!(s < tl)) { mab[e] = 0.f; mak[e] = 0.f; } if (!(s <= tl)) { nbr[e] = 0.f; nkr[e] = 0.f; } Mf[s * 16 + tl] = mab[e]; }
        { v2u o; o.x = pk2(mak[0], mak[1]); o.y = pk2(mak[2], mak[3]); *(v2u*)(rec + CH_MAK + (tl * 16 + 4 * g) * 2) = o;
          v4u n; n.x = pk2(nbr[0], nbr[1]); n.y = pk2(nbr[2], nbr[3]); n.z = pk2(nkr[0], nkr[1]); n.w = pk2(nkr[2], nkr[3]); *(v4u*)(rec + CH_NN + (tl * 4 + g) * 16) = n; }
        LDS_WAIT(); asm volatile("" ::: "memory");
        float Tc[16];
#pragma unroll
        for (int s = 15; s >= 0; --s) { float acc_ = (s == tl) ? 1.f : 0.f;
#pragma unroll
            for (int q = s + 1; q < 16; ++q) acc_ += Mf[s * 16 + q] * Tc[q];
            Tc[s] = acc_; }
        if (g == 0) { v4u o0, o1; o0.x = pk2(Tc[0], Tc[1]); o0.y = pk2(Tc[2], Tc[3]); o0.z = pk2(Tc[4], Tc[5]); o0.w = pk2(Tc[6], Tc[7]); o1.x = pk2(Tc[8], Tc[9]); o1.y = pk2(Tc[10], Tc[11]); o1.z = pk2(Tc[12], Tc[13]); o1.w = pk2(Tc[14], Tc[15]);
            *(v4u*)(rec + CH_TT + tl * 32) = o0; *(v4u*)(rec + CH_TT + tl * 32 + 16) = o1; }
        LDS_WAIT(); asm volatile("" ::: "memory");
    }
}

constexpr int YB_PITCH = 20;


constexpr int SQ_D = 7, SQ_AHEAD = SQ_D - 2, SQ_SLOT = CH_REC, YT_PITCH = 68;
__device__ __forceinline__ void scan_seq2(const Ctx& C, const unsigned char* CH, const float* ln_g, const float* ln_b, bf16* CAT) {
    const int bh = blockIdx.x; if (bh >= BATCH * RH) return;
    const int b = bh / RH, hh = bh % RH, lane = C.lane, w = C.wave, tl = lane & 15, g = lane >> 4;
    LAS unsigned char* ring = C.lds + RING_OFF;
    LAS float* Yb = (LAS float*)(C.lds + RING_OFF + SQ_D * SQ_SLOT);
    const unsigned char* rec0 = CH + (size_t)bh * 256 * CH_REC;
#define SQ_BAR() do { asm volatile("s_waitcnt lgkmcnt(0)" ::: "memory"); __builtin_amdgcn_s_barrier(); asm volatile("" ::: "memory"); } while (0)
    if (w < 4) {
        int pcs[4];
#pragma unroll
        for (int i = 0; i < 4; ++i) { int pidx = 4 * w + i; pcs[i] = (pidx > 14 ? 14 : pidx) * 1024; }
#define SQ_ISSUE(cc) do { const unsigned char* src = rec0 + (size_t)(cc) * CH_REC + lane * 16; LAS unsigned char* dst = ring + ((cc) % SQ_D) * SQ_SLOT; \
            _Pragma("unroll") for (int i = 0; i < 4; ++i) __builtin_amdgcn_global_load_lds((const unsigned*)(src + pcs[i]), (LAS unsigned*)(dst + pcs[i]), 16, 0, 0); } while (0)
#pragma unroll
        for (int cc = 0; cc < SQ_AHEAD; ++cc) SQ_ISSUE(cc);
        f32x4 S[4];
#pragma unroll
        for (int jt = 0; jt < 4; ++jt) S[jt] = (f32x4){0.f, 0.f, 0.f, 0.f};
        const int icol = 16 * w + tl;
        for (int c = 0; c < 256; ++c) {
            if (c + SQ_AHEAD - 1 < 256) asm volatile("s_waitcnt vmcnt(16)" ::: "memory");
            else asm volatile("s_waitcnt vmcnt(0)" ::: "memory");
            SQ_BAR();
            if (c + SQ_AHEAD < 256) SQ_ISSUE(c + SQ_AHEAD);
            const LAS unsigned char* rec = ring + (c % SQ_D) * SQ_SLOT;
            const bf16x8v cAt0 = *(const LAS bf16x8v*)(rec + CH_AT + tl * 128 + (8 * g) * 2), cAt1 = *(const LAS bf16x8v*)(rec + CH_AT + tl * 128 + (32 + 8 * g) * 2);
            const bf16x8v cRt0 = *(const LAS bf16x8v*)(rec + CH_RT + tl * 128 + (8 * g) * 2), cRt1 = *(const LAS bf16x8v*)(rec + CH_RT + tl * 128 + (32 + 8 * g) * 2);
            const bf16x8v cBK0 = *(const LAS bf16x8v*)(rec + CH_BK + ((tl) * 4 + g) * 16), cBK1 = *(const LAS bf16x8v*)(rec + CH_BK + ((16 + tl) * 4 + g) * 16);
            const bf16x8v cBK2 = *(const LAS bf16x8v*)(rec + CH_BK + ((32 + tl) * 4 + g) * 16), cBK3 = *(const LAS bf16x8v*)(rec + CH_BK + ((48 + tl) * 4 + g) * 16);
            const f32x4 cp0 = *(const LAS f32x4*)(rec + CH_PC + (4 * g) * 4), cp1 = *(const LAS f32x4*)(rec + CH_PC + (16 + 4 * g) * 4), cp2 = *(const LAS f32x4*)(rec + CH_PC + (32 + 4 * g) * 4), cp3 = *(const LAS f32x4*)(rec + CH_PC + (48 + 4 * g) * 4);
            const bf16x8v cN = *(const LAS bf16x8v*)(rec + CH_NN + (tl * 4 + g) * 16);
            const v2u cMak = *(const LAS v2u*)(rec + CH_MAK + (tl * 16 + 4 * g) * 2), cT = *(const LAS v2u*)(rec + CH_TT + (tl * 16 + 4 * g) * 2), cV = *(const LAS v2u*)(rec + CH_VT + (icol * 16 + 4 * g) * 2);
            v4u t4; bf16x8v sb0, sb1;
            t4.x = pk2(S[0][0], S[0][1]); t4.y = pk2(S[0][2], S[0][3]); t4.z = pk2(S[1][0], S[1][1]); t4.w = pk2(S[1][2], S[1][3]); sb0 = __builtin_bit_cast(bf16x8v, t4);
            t4.x = pk2(S[2][0], S[2][1]); t4.y = pk2(S[2][2], S[2][3]); t4.z = pk2(S[3][0], S[3][1]); t4.w = pk2(S[3][2], S[3][3]); sb1 = __builtin_bit_cast(bf16x8v, t4);
            t4.x = cMak.x; t4.y = cMak.y; t4.z = 0u; t4.w = 0u; const bf16x8v fMak = __builtin_bit_cast(bf16x8v, t4);
            t4.x = cV.x; t4.y = cV.y; t4.z = 0u; t4.w = 0u; const bf16x8v fV0 = __builtin_bit_cast(bf16x8v, t4);
            t4.x = cT.x; t4.y = cT.y; t4.z = 0u; t4.w = 0u; const bf16x8v fT = __builtin_bit_cast(bf16x8v, t4);
            f32x4 Z = (f32x4){0.f, 0.f, 0.f, 0.f};
            Z = __builtin_amdgcn_mfma_f32_16x16x32_bf16(fMak, fV0, Z, 0, 0, 0);
            Z = __builtin_amdgcn_mfma_f32_16x16x32_bf16(cAt0, sb0, Z, 0, 0, 0);
            Z = __builtin_amdgcn_mfma_f32_16x16x32_bf16(cAt1, sb1, Z, 0, 0, 0);
            f32x4 Y = (f32x4){0.f, 0.f, 0.f, 0.f};
            Y = __builtin_amdgcn_mfma_f32_16x16x32_bf16(cRt0, sb0, Y, 0, 0, 0);
            Y = __builtin_amdgcn_mfma_f32_16x16x32_bf16(cRt1, sb1, Y, 0, 0, 0);
            t4.x = pk2(Z[0], Z[1]); t4.y = pk2(Z[2], Z[3]); t4.z = 0u; t4.w = 0u;
            f32x4 U = (f32x4){0.f, 0.f, 0.f, 0.f};
            U = __builtin_amdgcn_mfma_f32_16x16x32_bf16(fT, __builtin_bit_cast(bf16x8v, t4), U, 0, 0, 0);
            t4.x = pk2(U[0], U[1]); t4.y = pk2(U[2], U[3]); t4.z = cV.x; t4.w = cV.y; const bf16x8v buv = __builtin_bit_cast(bf16x8v, t4);
            S[0] = S[0] * cp0; S[1] = S[1] * cp1; S[2] = S[2] * cp2; S[3] = S[3] * cp3;
            S[0] = __builtin_amdgcn_mfma_f32_16x16x32_bf16(cBK0, buv, S[0], 0, 0, 0); S[1] = __builtin_amdgcn_mfma_f32_16x16x32_bf16(cBK1, buv, S[1], 0, 0, 0);
            S[2] = __builtin_amdgcn_mfma_f32_16x16x32_bf16(cBK2, buv, S[2], 0, 0, 0); S[3] = __builtin_amdgcn_mfma_f32_16x16x32_bf16(cBK3, buv, S[3], 0, 0, 0);
            Y = __builtin_amdgcn_mfma_f32_16x16x32_bf16(cN, buv, Y, 0, 0, 0);
#pragma unroll
            for (int e = 0; e < 4; ++e) Yb[(c & 1) * 16 * YT_PITCH + (4 * g + e) * YT_PITCH + icol] = Y[e];
        }
        SQ_BAR();
#undef SQ_ISSUE
    } else {
        const int pw = w - 4, tq = lane >> 4, iq = lane & 15, tt = 4 * pw + tq, cj = hh * 64 + 4 * iq;
        const f32x4 lng = *(const f32x4*)(ln_g + cj), lnb = *(const f32x4*)(ln_b + cj);
        for (int c = 0; c <= 256; ++c) {
            SQ_BAR();
            if (c > 0) { const LAS unsigned char* rec = ring + ((c - 1) % SQ_D) * SQ_SLOT;
                const f32x4 y4 = *(const LAS f32x4*)(Yb + ((c - 1) & 1) * 16 * YT_PITCH + tt * YT_PITCH + 4 * iq);
                const float bo = *(const LAS float*)(rec + CH_BON + tt * 4);
                float vv[4], gv[4];
#pragma unroll
                for (int e = 0; e < 4; ++e) { vv[e] = bf2f(*(const LAS unsigned short*)(rec + CH_VT + ((4 * iq + e) * 16 + tt) * 2)); gv[e] = bf2f(*(const LAS unsigned short*)(rec + CH_G + ((4 * iq + e) * 16 + tt) * 2)); }
                const float s1 = row16_sum((y4[0] + y4[1]) + (y4[2] + y4[3])), s2 = row16_sum((y4[0] * y4[0] + y4[1] * y4[1]) + (y4[2] * y4[2] + y4[3] * y4[3]));
                const float mean = s1 * (1.f / 64.f), var = fmaxf(s2 * (1.f / 64.f) - mean * mean, 0.f), rstd = __builtin_amdgcn_rsqf(var + GN_EPS);
                float o[4];
#pragma unroll
                for (int e = 0; e < 4; ++e) o[e] = ((y4[e] - mean) * rstd * lng[e] + lnb[e] + bo * vv[e]) * gv[e];
                const size_t row = (size_t)b * SEQ + 16 * (c - 1) + tt;
                v2u ow; ow.x = pk2(o[0], o[1]); ow.y = pk2(o[2], o[3]); *(v2u*)(CAT + row * DM + cj) = ow; }
        }
    }
#undef SQ_BAR
}

__device__ __forceinline__ void xattn_lds(const Ctx& C, const bf16* P, int cqoff, const bf16* MEMKV, const bf16* MEMVT, bf16* CAT, int ldc, int catoff, int u0, int ustride) {
    constexpr int KP = 528, VP = 272;
    const int lane = C.lane, w = C.wave, c = lane & 15, g = lane >> 4, tid = C.tid;
    LAS unsigned char* Ls = C.lds + RING_OFF;
    for (int u = u0; u < 256; u += ustride) {
        const int b = u >> 7, xh = (u >> 5) & 3, qb = u & 31;
        const int qrow = b * SEQ + qb * 128 + w * 16 + c;
        bf16x8v qf[8];
        { const bf16* qp = P + (size_t)qrow * LDP + cqoff + xh * 256 + 8 * g;
#pragma unroll
          for (int ks = 0; ks < 8; ++ks) qf[ks] = *(const bf16x8v*)(qp + 32 * ks); }
        f32x4 s[16];
#pragma unroll
        for (int kt = 0; kt < 16; ++kt) s[kt] = (f32x4){0.f, 0.f, 0.f, 0.f};
#pragma unroll
        for (int half = 0; half < 2; ++half) {
            v4u stg[8];
#pragma unroll
            for (int it = 0; it < 8; ++it) { const int idx = it * 512 + tid, row = idx >> 5, c16 = idx & 31;
                stg[it] = *(const v4u*)(MEMKV + (size_t)(b * 256 + half * 128 + row) * 2048 + xh * 256 + c16 * 8); }
            __syncthreads();
#pragma unroll
            for (int it = 0; it < 8; ++it) { const int idx = it * 512 + tid, row = idx >> 5, c16 = idx & 31; *(LAS v4u*)(Ls + row * KP + c16 * 16) = stg[it]; }
            __syncthreads();
#pragma unroll
            for (int kt = 0; kt < 8; ++kt) {
#pragma unroll
                for (int ks = 0; ks < 8; ++ks) { const bf16x8v kf = *(const LAS bf16x8v*)(Ls + (16 * kt + c) * KP + (32 * ks + 8 * g) * 2);
                    s[8 * half + kt] = __builtin_amdgcn_mfma_f32_16x16x32_bf16(kf, qf[ks], s[8 * half + kt], 0, 0, 0); }
                asm volatile("" ::: "memory"); }
        }
        float m = -1e30f;
#pragma unroll
        for (int kt = 0; kt < 16; ++kt) m = fmaxf(fmaxf(m, fmaxf(s[kt][0], s[kt][1])), fmaxf(s[kt][2], s[kt][3]));
        m = fmaxf(m, __shfl_xor(m, 16)); m = fmaxf(m, __shfl_xor(m, 32));
        float l = 0.f; const float sc = 0.0625f * 1.4426950408889634f;
        bf16x8v pf[8];
#pragma unroll
        for (int kk = 0; kk < 8; ++kk) { float p[8];
#pragma unroll
            for (int r = 0; r < 4; ++r) { p[r] = __builtin_amdgcn_exp2f((s[2 * kk][r] - m) * sc); p[4 + r] = __builtin_amdgcn_exp2f((s[2 * kk + 1][r] - m) * sc); }
#pragma unroll
            for (int r = 0; r < 8; ++r) l += p[r];
            v4u pw; pw.x = pk2(p[0], p[1]); pw.y = pk2(p[2], p[3]); pw.z = pk2(p[4], p[5]); pw.w = pk2(p[6], p[7]);
            pf[kk] = __builtin_bit_cast(bf16x8v, pw); }
        l += __shfl_xor(l, 16); l += __shfl_xor(l, 32);
        const float inv = 1.f / l;
        f32x4 o[16];
#pragma unroll
        for (int dt = 0; dt < 16; ++dt) o[dt] = (f32x4){0.f, 0.f, 0.f, 0.f};
#pragma unroll
        for (int half = 0; half < 2; ++half) {
            v4u stg[8];
#pragma unroll
            for (int it = 0; it < 8; ++it) { const int idx = it * 512 + tid, key = idx >> 5, d8 = idx & 31;
                stg[it] = *(const v4u*)(MEMKV + (size_t)(b * 256 + half * 128 + key) * 2048 + 1024 + xh * 256 + d8 * 8); }
            __syncthreads();
#pragma unroll
            for (int it = 0; it < 8; ++it) { const int idx = it * 512 + tid, key = idx >> 5, d8 = idx & 31;
#pragma unroll
                for (int e = 0; e < 8; ++e) { const unsigned wv = stg[it][e >> 1]; *(LAS unsigned short*)(Ls + (8 * d8 + e) * VP + key * 2) = (unsigned short)((e & 1) ? (wv >> 16) : (wv & 0xffffu)); } }
            __syncthreads();
#pragma unroll
            for (int dt = 0; dt < 16; ++dt) {
#pragma unroll
                for (int kk = 0; kk < 4; ++kk) { const LAS unsigned char* vp = Ls + (16 * dt + c) * VP + (32 * kk + 4 * g) * 2;
                    const v2u lo = *(const LAS v2u*)vp, hi = *(const LAS v2u*)(vp + 32);
                    v4u vw; vw.x = lo.x; vw.y = lo.y; vw.z = hi.x; vw.w = hi.y;
                    o[dt] = __builtin_amdgcn_mfma_f32_16x16x32_bf16(__builtin_bit_cast(bf16x8v, vw), pf[4 * half + kk], o[dt], 0, 0, 0); }
                if (dt & 1) asm volatile("" ::: "memory"); }
        }
        bf16* op = CAT + (size_t)qrow * ldc + catoff + xh * 256 + 4 * g;
#pragma unroll
        for (int dt = 0; dt < 16; ++dt) { v2u ow; ow.x = pk2(o[dt][0] * inv, o[dt][1] * inv); ow.y = pk2(o[dt][2] * inv, o[dt][3] * inv); *(v2u*)(op + dt * 16) = ow; }
    }
}

namespace pg8 {
struct EpiAin {
    static constexpr bool PERM = true, AFTER_DRAIN = false;
    bf16_t* P; bf16_t* VF; const float* ROPE; bf16_t* KB2;
    __device__ __forceinline__ void operator()(const f32x4 (&acc)[2][2][4][2], const Unit& u, int, int, int, int) const {
        int t_ = threadIdx.x; asm volatile("" : "+v"(t_)); const int wid_ = __builtin_amdgcn_readfirstlane(t_ >> 6), wr = wid_ >> 2, wc = wid_ & 3, fr = t_ & 15, fq = (t_ >> 4) & 3;
        const int row0 = u.pm * BM + wr * 64 + fr; const int colt = u.pn * BM + wc * 32 + 8 * fq;
        const bool is_v = (u.pn >= 24 && u.pn < 36), is_k = (u.pn >= 12 && u.pn < 24), rot = (u.pn < 24) && (wc == 0);
        bf16_t* base = is_v ? (VF + (colt - PA_V)) : (P + colt); const int ldo = is_v ? MIXW : LDP;
#pragma unroll
        for (int ai = 0; ai < 2; ++ai)
#pragma unroll
            for (int m = 0; m < 4; ++m) { const int row = row0 + ai * HALF + m * 16;
                f32x4 cs[4];
                if (rot) { const float* tp = ROPE + ((size_t)row * 16 + 8 * (fq & 1)) * 2;
#pragma unroll
                    for (int q4 = 0; q4 < 4; ++q4) cs[q4] = *(const f32x4*)(tp + 4 * q4); }
#pragma unroll
                for (int bj = 0; bj < 2; ++bj) { f32x4 v0 = acc[ai][bj][m][0], v1 = acc[ai][bj][m][1];
                    if (rot) { float x[8] = {v0[0], v0[1], v0[2], v0[3], v1[0], v1[1], v1[2], v1[3]};
#pragma unroll
                        for (int e = 0; e < 8; ++e) { const float other = __shfl_xor(x[e], 32); const float cc = cs[e >> 1][2 * (e & 1)], ss = cs[e >> 1][2 * (e & 1) + 1];
                            x[e] = (fq < 2) ? (x[e] * cc - other * ss) : (x[e] * cc + other * ss); }
                        v0 = (f32x4){x[0], x[1], x[2], x[3]}; v1 = (f32x4){x[4], x[5], x[6], x[7]}; }
                    u32x4 w; w.x = cvt_pk_bf16(v0[0], v0[1]); w.y = cvt_pk_bf16(v0[2], v0[3]); w.z = cvt_pk_bf16(v1[0], v1[1]); w.w = cvt_pk_bf16(v1[2], v1[3]);
                    if (is_k) { const int hk = (u.pn - 12) * 2 + bj, ldk_ = 2 * (hk >> 3), tt = row & (SEQ - 1), idx = (tt & ((1 << ldk_) - 1)) * (SEQ >> ldk_) + (tt >> ldk_);
                        *(u32x4*)(KB2 + (size_t)((row >> 12) * 24 + hk) * (128 * SEQ) + (size_t)(idx >> 4) * 2048 + wc * 512 + (idx & 15) * 32 + fq * 8) = w; }
                    else *(u32x4*)(base + (size_t)row * ldo + bj * HALF) = w; }
                asm volatile("" ::: "memory"); }
    }
};
}
constexpr int N_PHASES = 24;
constexpr int WUP1_SPLIT = 6144;
#ifndef REP_CONV
#define REP_CONV 1
#endif
#ifndef REP_ATT
#define REP_ATT 1
#endif
#ifndef REP_SCAN
#define REP_SCAN 1
#endif
#ifndef REP_CACT
#define REP_CACT 1
#endif
#ifndef REP_SONLY
#define REP_SONLY 1
#endif
#ifndef REP_SPRE
#define REP_SPRE 1
#endif
#ifndef REP_LORA
#define REP_LORA 1
#endif
#ifndef REP_UP
#define REP_UP 1
#endif
struct Args { const void* in[30]; float* out; unsigned char* ws; int ph_lo, ph_hi; };
__global__ void __launch_bounds__(NTHREADS, 2) mk_fwd(Args args) {
    extern __shared__ __attribute__((aligned(16))) unsigned char lds_raw[];
    LAS unsigned char* const ldsb = (LAS unsigned char*)lds_raw;
#define MKCTX() Ctx C; { int t_ = threadIdx.x; asm volatile("" : "+v"(t_)); int b_ = blockIdx.x; asm volatile("" : "+s"(b_)); C.lds = ldsb; C.tid = t_; C.lane = t_ & 63; C.wave = __builtin_amdgcn_readfirstlane(t_ >> 6); \
        C.gw = b_ * NWAVES + C.wave; C.NGW = gridDim.x * NWAVES; C.gtid = b_ * NTHREADS + t_; C.GT = gridDim.x * NTHREADS; }
    const int G = gridDim.x, bx = blockIdx.x;
    unsigned char* ws = args.ws;
    gu32* ctl = (gu32*)(ws + WS_CTL);
    volatile LAS unsigned* MISC = (volatile LAS unsigned*)(ldsb + MISC_OFF);
    for (int u = threadIdx.x; u < (LDS_BYTES - LDSCTL_OFF) / 4; u += NTHREADS) ((LAS unsigned*)(ldsb + LDSCTL_OFF))[u] = 0u;
    __syncthreads();
    const int lo = args.ph_lo, hi = args.ph_hi;
    const bool multi = (hi - lo) > 1;
    XcdBarrier bar; bar.bar = (unsigned*)(ctl + CW_BAR); bar.x = 0; bar.st = nullptr;
    if (multi) bar = xcd_barrier_post((unsigned*)(ctl + CW_BAR), MISC + 8);
#ifdef ONLY_PH
#define IN(k) ((k) == ONLY_PH && lo <= (k) && (k) < hi)
#else
#define IN(k) (lo <= (k) && (k) < hi)
#endif
#define SEAM(k) do { if (IN(k) && IN((k) + 1)) xcd_barrier(bar); } while (0)

    constexpr size_t WUP_L = (size_t)DFF2 * DM, WDOWN_L = (size_t)DM * DFF;
#define CAS __attribute__((address_space(4)))
#define KARG_DECL() const CAS char* ka_ = (const CAS char*)__builtin_amdgcn_kernarg_segment_ptr(); asm volatile("" : "+s"(ka_))
#define INF(k) (*(const float* const CAS*)(ka_ + 8 * (k)))
#define WSB(off) ((bf16*)(ws + (off)))
#define WSF(off) ((float*)(ws + (off)))
#define GEMM_BF16(Ap, lda_, Btp, ldb_, M_, N_, K_, Op, ldc_) do { pg8::Gemm g{(const pg8::bf16_t*)(Ap), (const pg8::bf16_t*)(Btp), (M_), (N_), (K_), (lda_), (ldb_)}; \
        pg8::StaticOrder S; S.init((M_), (N_), G, bx); pg8::EpiBf16P E{(pg8::bf16_t*)(Op), (ldc_)}; \
        pg8::gemm_phase<pg8::EpiBf16P, pg8::StaticOrder, true>(ldsb + RING_OFF, g, S, E); } while (0)
#define GEMM_RESB(RF32, Ap, lda_, Btp, K_, Rp) do { pg8::Gemm g{(const pg8::bf16_t*)(Ap), (const pg8::bf16_t*)(Btp), NTOK, DM, (K_), (lda_), (K_)}; \
        pg8::StaticOrder S; S.init(NTOK, DM, G, bx); pg8::EpiResB<RF32> E{(pg8::bf16_t*)WSB(WS_X), (const void*)(Rp)}; \
        pg8::gemm_phase<pg8::EpiResB<RF32>, pg8::StaticOrder, true>(ldsb + RING_OFF, g, S, E); } while (0)
#define GEMM_F32(Ap, lda_, Btp, ldb_, M_, N_, K_, Op, Rp, ldc_) do { pg8::Gemm g{(const pg8::bf16_t*)(Ap), (const pg8::bf16_t*)(Btp), (M_), (N_), (K_), (lda_), (ldb_)}; \
        pg8::StaticOrder S; S.init((M_), (N_), G, bx); pg8::EpiF32 E{(Op), (Rp), (ldc_)}; \
        pg8::gemm_phase<pg8::EpiF32, pg8::StaticOrder, true>(ldsb + RING_OFF, g, S, E); } while (0)

#define GEMM_CONVACT(Ap, Btp, cwp, cbp) do { pg8::Gemm g{(const pg8::bf16_t*)(Ap), (const pg8::bf16_t*)(Btp), NTOK, DFF2, DM, DM, DM}; \
        pg8::StaticOrder S; S.init(NTOK, DFF2, G, bx); pg8::EpiConvAct E{(pg8::bf16_t*)WSB(WS_ACT), WSF(WS_HALO), WSF(WS_RAWG), WSF(WS_RAWU), (cwp), (cbp)}; \
        pg8::gemm_phase<pg8::EpiConvAct, pg8::StaticOrder, true>(ldsb + RING_OFF, g, S, E); } while (0)

    if (IN(0)) { MKCTX(); KARG_DECL();
        for (int rep_ = 0; rep_ < REP_CONV; ++rep_) {
        convert_fast(C, INF(4), DM, 2048, WSB(WS_WKV), DM, 0);
        convert_fast(C, INF(6), DM, A_IN, WSB(WS_WAIN), DM, 0);
        convert_fast(C, INF(7), A_CAT, DM, WSB(WS_WAOUT), A_CAT, 0);
        convert_fast(C, INF(9), DM, B_IN, WSB(WS_WBIN), DM, 0);
        convert_job(C, INF(12), 128, MIXW, WSB(WS_WLW), 256, 0, 256, 0);
        convert_job(C, INF(14), 128, MIXW, WSB(WS_WLA), 256, 128, 256, 0);
        convert_job(C, INF(16), 96, MIXW, WSB(WS_WLV), 256, 0, 256, 0);
        convert_job(C, INF(17), 480, MIXW, WSB(WS_WLG), 512, 0, 512, 0);
        convert_fast(C, INF(25), DM, DFF2, WSB(WS_WUP), DM, 1);
        convert_fast(C, INF(28), DFF, DM, WSB(WS_WDOWN), DFF, 0);
        }
        rope_table(C, (const int*)INF(2), WSF(WS_ROPE));
        rmsnorm_rows<false>(C, INF(1), INF(3), WSB(WS_MEMN), NMEM);
        rmsnorm_rows<false>(C, INF(0), INF(5), WSB(WS_H), NTOK);
    }
    SEAM(0);
    if (IN(2)) { pg8::Gemm g{(const pg8::bf16_t*)WSB(WS_H), (const pg8::bf16_t*)WSB(WS_WAIN), NTOK, A_IN, DM, DM, DM};
        pg8::StaticOrder S; S.init(NTOK, A_IN, G, bx); pg8::EpiAin E{(pg8::bf16_t*)WSB(WS_P), (pg8::bf16_t*)WSB(WS_VFIRST), WSF(WS_ROPE), (pg8::bf16_t*)WSB(WS_Y)};
        pg8::gemm_phase<pg8::EpiAin, pg8::StaticOrder, true>(ldsb + RING_OFF, g, S, E); }
    SEAM(2);
    if (IN(3)) {
        if (bx < 16) GEMM_BF16(WSB(WS_MEMN), DM, WSB(WS_WKV), DM, NMEM, 2048, DM, WSB(WS_MEMKV), 2048);
        else { MKCTX(); KARG_DECL(); vt_build(C, WSB(WS_VFIRST), WSB(WS_VT), (bx - 16) * NWAVES + C.wave, (G - 16) * NWAVES);
            convert_fast(C, INF(28) + WDOWN_L, DFF, DM, WSB(WS_WDOWN) + WDOWN_L, DFF, 0, (bx - 16) * NWAVES + C.wave, (G - 16) * NWAVES); }
    }
    SEAM(3);
    if (IN(4)) for (int rep_ = 0; rep_ < REP_ATT; ++rep_) { MKCTX(); KARG_DECL(); attn_mfma(C, WSB(WS_P), WSB(WS_Y), WSB(WS_VT), WSB(WS_CAT)); xattn_lds(C, WSB(WS_P), PA_CQ, WSB(WS_MEMKV), WSB(WS_MEMKV), WSB(WS_CAT), A_CAT, A_OUTW, (G % 8 == 0) ? (bx % 8) * (G / 8) + bx / 8 : bx, G); }
    SEAM(4);
    if (IN(6)) { KARG_DECL(); GEMM_RESB(true, WSB(WS_CAT), A_CAT, WSB(WS_WAOUT), A_CAT, INF(0)); }
    SEAM(6);
    if (IN(7)) { MKCTX(); KARG_DECL(); rmsnorm_rows_b<false>(C, WSB(WS_X), INF(24), WSB(WS_H), NTOK); }
    SEAM(7);
    if (IN(8)) { KARG_DECL(); for (int rep_ = 0; rep_ < REP_UP; ++rep_) GEMM_CONVACT(WSB(WS_H), WSB(WS_WUP), INF(26), INF(27)); }
    SEAM(8);
    if (IN(9)) { MKCTX(); KARG_DECL(); convact_fixup(C, WSF(WS_HALO), WSF(WS_RAWG), WSF(WS_RAWU), INF(26), INF(27), WSB(WS_ACT)); }
    SEAM(9);
    if (IN(10)) GEMM_RESB(false, WSB(WS_ACT), DFF, WSB(WS_WDOWN), DFF, WSB(WS_X));
    SEAM(10);
    if (IN(11)) { MKCTX(); KARG_DECL(); rmsnorm_rows_b<false>(C, WSB(WS_X), INF(8), WSB(WS_H), NTOK); }
    SEAM(11);
    if (IN(12)) { GEMM_BF16(WSB(WS_H), DM, WSB(WS_WBIN), DM, NTOK, B_IN_PAD, DM, WSB(WS_P), LDP);
        if (bx >= 128) { MKCTX(); KARG_DECL();
            const int cgw = (bx - 128) * NWAVES + C.wave, cng = (G - 128) * NWAVES;
            convert_fast(C, INF(23), DM, DM, WSB(WS_WBOUT), DM, 0, cgw, cng);
            convert_fast(C, INF(25) + WUP_L, DM, DFF2, WSB(WS_WUP) + WUP_L, DM, 1, cgw, cng, 0, WUP1_SPLIT); } }
    SEAM(12);
    if (IN(13)) for (int rl_ = 0; rl_ < REP_LORA; ++rl_) { MKCTX(); KARG_DECL(); prep_b1(C, WSB(WS_P), INF(10), WSB(WS_LA)); }
    SEAM(13);
    if (IN(14)) for (int rl_ = 0; rl_ < REP_LORA; ++rl_) { KARG_DECL();
#define GEMM_LORA(MODE, Ap, Btp, K_, Op, biasp) GEMM_LORA2(MODE, MIXW, Ap, Btp, K_, Op, biasp, (pg8::bf16_t*)nullptr, (const float*)nullptr)
#define GEMM_LORA2(MODE, N_, Ap, Btp, K_, Op, biasp, O2p, bias2p) do { int kv_ = (K_); asm volatile("" : "+s"(kv_)); pg8::Gemm g{(const pg8::bf16_t*)(Ap), (const pg8::bf16_t*)(Btp), NTOK, (N_), kv_, 1024, kv_}; \
        pg8::StaticOrder S; S.init(NTOK, (N_), G, bx); pg8::EpiLora<MODE> E{(pg8::bf16_t*)(Op), (biasp), (const pg8::bf16_t*)WSB(WS_P), INF(10), (const pg8::bf16_t*)WSB(WS_VFIRST), (pg8::bf16_t*)(O2p), (bias2p)}; \
        pg8::gemm_phase<pg8::EpiLora<MODE>, pg8::StaticOrder, true>(ldsb + RING_OFF, g, S, E); } while (0)
        GEMM_LORA2(4, 2 * MIXW, WSB(WS_LA), WSB(WS_WLW), 256, WSF(WS_SW), INF(11), WSF(WS_SA), INF(13));
        GEMM_LORA(2, WSB(WS_LA) + 256, WSB(WS_WLV), 256, WSF(WS_SV), INF(15));
        GEMM_LORA(3, WSB(WS_LA) + 512, WSB(WS_WLG), 512, WSF(WS_G), (const float*)nullptr);
    }
    SEAM(14);
    if (IN(15)) for (int rp_ = 0; rp_ < REP_SPRE; ++rp_) { MKCTX(); KARG_DECL(); scan_pre(C, WSB(WS_P), INF(10), INF(18), INF(19), INF(20), WSB(WS_SW), WSB(WS_SA), WSB(WS_SV), WSB(WS_G), ws + WS_CH); }
    SEAM(15);
    if (IN(17)) for (int rep_ = 0; rep_ < REP_SCAN; ++rep_) { MKCTX(); KARG_DECL();
        if (bx < BATCH * RH) for (int rs_ = 0; rs_ < REP_SONLY; ++rs_) scan_seq2(C, ws + WS_CH, INF(21), INF(22), WSB(WS_CAT));
        else { xattn_lds(C, WSB(WS_P), PB_CQ, WSB(WS_MEMKV), WSB(WS_MEMKV), WSB(WS_CAT), DM, MIXW, bx - BATCH * RH, G - BATCH * RH);
            __syncthreads();
            const int cgw = (bx - BATCH * RH) * NWAVES + C.wave, cng = (G - BATCH * RH) * NWAVES;
            convert_fast(C, INF(25) + WUP_L, DM, DFF2, WSB(WS_WUP) + WUP_L, DM, 1, cgw, cng, WUP1_SPLIT);
            }
    }
    SEAM(17);
    if (IN(18)) GEMM_RESB(false, WSB(WS_CAT), DM, WSB(WS_WBOUT), DM, WSB(WS_X));
    SEAM(18);
    if (IN(19)) { MKCTX(); KARG_DECL(); rmsnorm_rows_b<false>(C, WSB(WS_X), INF(24) + DM, WSB(WS_H), NTOK); }
    SEAM(19);
    if (IN(20)) { KARG_DECL(); for (int rep_ = 0; rep_ < REP_UP; ++rep_) GEMM_CONVACT(WSB(WS_H), WSB(WS_WUP) + WUP_L, INF(26) + 3 * DFF, INF(27) + DFF); }
    SEAM(20);
    if (IN(21)) { MKCTX(); KARG_DECL(); convact_fixup(C, WSF(WS_HALO), WSF(WS_RAWG), WSF(WS_RAWU), INF(26) + 3 * DFF, INF(27) + DFF, WSB(WS_ACT)); }
    SEAM(21);
    if (IN(22)) GEMM_RESB(false, WSB(WS_ACT), DFF, WSB(WS_WDOWN) + WDOWN_L, DFF, WSB(WS_X));
    SEAM(22);
    if (IN(23)) { MKCTX(); KARG_DECL(); rmsnorm_rows_b<true>(C, WSB(WS_X), INF(29), (void*)INF(30), NTOK); }
#undef IN
#undef SEAM
}

#ifndef MK_ONE_LAUNCH
#define MK_ONE_LAUNCH 0
#endif
extern "C" void kernel_launch(void* const* d_in, const int* in_sizes, int n_in, void* d_out, int out_size, void* d_ws, size_t ws_size, hipStream_t stream) {
    static int grid = 0;
    if (grid == 0) {
        if (n_in != 30 || out_size != NTOK * DM || ws_size < WS_END) { fprintf(stderr, "kernel_launch: unexpected shapes: n_in %d out %d ws %zu (need %zu)\n", n_in, out_size, ws_size, (size_t)WS_END); grid = -1; return; }
        int dev = 0, cus = 0, per_cu = 0;
        if (hipGetDevice(&dev) != hipSuccess || hipDeviceGetAttribute(&cus, hipDeviceAttributeMultiprocessorCount, dev) != hipSuccess) { grid = -1; return; }
        if (hipFuncSetAttribute((const void*)mk_fwd, hipFuncAttributeMaxDynamicSharedMemorySize, LDS_BYTES) != hipSuccess) { fprintf(stderr, "kernel_launch: hipFuncSetAttribute failed\n"); grid = -1; return; }
        if (hipOccupancyMaxActiveBlocksPerMultiprocessor(&per_cu, (const void*)mk_fwd, NTHREADS, LDS_BYTES) != hipSuccess || per_cu < 1) { fprintf(stderr, "kernel_launch: occupancy query says %d\n", per_cu); }
        (void)hipGetLastError();
        grid = cus;
    }
    if (grid < 0) return;
    (void)hipMemsetAsync((char*)d_ws + WS_CTL, 0, CTL_ZERO_BYTES, stream);
    Args a{};
    for (int i = 0; i < 30; ++i) a.in[i] = d_in[i];
    a.out = (float*)d_out; a.ws = (unsigned char*)d_ws;
#if MK_ONE_LAUNCH
    a.ph_lo = 0; a.ph_hi = N_PHASES;
    hipLaunchKernelGGL(mk_fwd, dim3(grid), dim3(NTHREADS), LDS_BYTES, stream, a);
#else
    for (int p = 0; p < N_PHASES; ++p) { a.ph_lo = p; a.ph_hi = p + 1; hipLaunchKernelGGL(mk_fwd, dim3(grid), dim3(NTHREADS), LDS_BYTES, stream, a); }
#endif
}
```
